# Optimizing an MI355X kernel written in HIP

```python
import math
import jax, jax.numpy as jnp
from jax import lax
import numpy as np

D_MODEL = 1024
BATCH = 2
SEQ = 8192
DEPTH = 1

N_META = 16
NORM_EPS = 1e-6
ATT_HEADS = 8
ATT_QK_DIM = 64
ATT_V_DIM = 2 * ATT_QK_DIM
ATT_QK_WIDTH = ATT_HEADS * 2 * ATT_QK_DIM
ATT_WIDTH = ATT_HEADS * ATT_V_DIM
Q_BLOCK = 128
DN_HEADS = 8
DN_K_DIM = 128
DN_V_DIM = 128
DN_KEY_WIDTH = DN_HEADS * DN_K_DIM
DN_WIDTH = DN_HEADS * DN_V_DIM
DN_CONV = 4
DN_CONV_CH = 2 * DN_KEY_WIDTH + DN_WIDTH
DN_CHUNK = 64
IN_SIZES = (ATT_QK_WIDTH, ATT_QK_WIDTH, ATT_WIDTH, ATT_WIDTH,
            DN_KEY_WIDTH, DN_KEY_WIDTH, DN_WIDTH, DN_WIDTH, DN_HEADS, DN_HEADS,
            D_MODEL, D_MODEL)
IN_DIM = sum(IN_SIZES)

kernel_name = 'hybrid_diffattn_gdn_block'


def rms_norm(x, w):
    xf = x.astype(jnp.float32)
    y = xf * lax.rsqrt(jnp.mean(xf * xf, axis=-1, keepdims=True) + NORM_EPS)
    return (y * w.astype(jnp.float32)).astype(x.dtype)


def l2_normalize(x):
    xf = x.astype(jnp.float32)
    return (xf * lax.rsqrt(jnp.sum(xf * xf, axis=-1, keepdims=True) + 1e-6)).astype(x.dtype)


def causal_depthwise_conv(x, w):
    K, C = w.shape
    return lax.conv_general_dilated(x, w[:, None, :].astype(x.dtype), window_strides=(1,),
                                    padding=[(K - 1, 0)], dimension_numbers=('NWC', 'WIO', 'NWC'),
                                    feature_group_count=C)


def diff_attention(q, k, v, lam):
    B, L, H, _, dh = q.shape
    nb = -(-L // Q_BLOCK)
    lq = nb * Q_BLOCK
    qp = jnp.pad(q, ((0, 0), (0, lq - L), (0, 0), (0, 0), (0, 0)))
    qb = qp.reshape(B, nb, Q_BLOCK, H, 2, dh).transpose(1, 0, 2, 3, 4, 5)
    k_pos = jnp.arange(L)
    scale = dh ** -0.5

    def one_block(args):
        q_blk, start = args
        s = jnp.einsum('bqhmd,bkhmd->bhmqk', q_blk, k).astype(jnp.float32) * scale
        q_pos = start + jnp.arange(Q_BLOCK)
        causal = k_pos[None, :] <= q_pos[:, None]
        p = jax.nn.softmax(jnp.where(causal, s, -jnp.inf), axis=-1)
        pd = p[:, :, 0] - lam * p[:, :, 1]
        return jnp.einsum('bhqk,bkhd->bqhd', pd.astype(v.dtype), v)

    out = lax.map(one_block, (qb, jnp.arange(nb) * Q_BLOCK))
    return out.transpose(1, 0, 2, 3, 4).reshape(B, lq, H, -1)[:, :L]


def gated_delta_chunked(q, k, v, beta, g):
    B, Lp, H, dk = q.shape
    dv = v.shape[-1]
    n = Lp // DN_CHUNK

    def chunks(t):
        return t.reshape(B, n, DN_CHUNK, H, -1).transpose(0, 3, 1, 2, 4).astype(jnp.float32)

    q, k, v = chunks(q), chunks(k), chunks(v)
    beta = chunks(beta[..., None])[..., 0]
    gc = jnp.cumsum(chunks(g[..., None])[..., 0], axis=-1)
    incl = jnp.tril(jnp.ones((DN_CHUNK, DN_CHUNK), dtype=bool))
    strict = jnp.tril(jnp.ones((DN_CHUNK, DN_CHUNK), dtype=bool), -1)
    diff = gc[..., :, None] - gc[..., None, :]
    decay = jnp.where(incl, jnp.exp(jnp.where(incl, diff, 0.0)), 0.0)
    kb = k * beta[..., None]
    m = jnp.where(strict, jnp.einsum('bhnid,bhnjd->bhnij', kb, k) * decay, 0.0)
    eye = jnp.eye(DN_CHUNK, dtype=jnp.float32)
    t_inv = lax.linalg.triangular_solve(m + eye, jnp.broadcast_to(eye, m.shape), left_side=True,
                                        lower=True, unit_diagonal=True)
    u = jnp.einsum('bhnij,bhnjd->bhnid', t_inv, v * beta[..., None])
    w = jnp.einsum('bhnij,bhnjd->bhnid', t_inv, kb * jnp.exp(gc)[..., None])
    a_intra = jnp.einsum('bhnid,bhnjd->bhnij', q, k) * decay
    q_dec = q * jnp.exp(gc)[..., None]
    k_dec = k * jnp.exp(gc[..., -1:] - gc)[..., None]
    chunk_decay = jnp.exp(gc[..., -1])

    def step(state, inp):
        u_c, w_c, a_c, qd_c, kd_c, cd_c = inp
        v_new = u_c - jnp.einsum('bhcd,bhde->bhce', w_c, state)
        o_c = jnp.einsum('bhcd,bhde->bhce', qd_c, state) + jnp.einsum('bhij,bhje->bhie', a_c, v_new)
        state = state * cd_c[..., None, None] + jnp.einsum('bhcd,bhce->bhde', kd_c, v_new)
        return state, o_c

    xs = tuple(jnp.moveaxis(t, 2, 0) for t in (u, w, a_intra, q_dec, k_dec, chunk_decay))
    s0 = jnp.zeros((B, H, dk, dv), jnp.float32)
    _, o = lax.scan(step, s0, xs)
    return o.transpose(1, 0, 3, 2, 4).reshape(B, Lp, H, dv)


def hybrid_layer(h, layer_idx, norm_w, w_in, lambda_q1, lambda_k1, lambda_q2, lambda_k2,
                 attn_norm_w, conv_w, a_log, dt_bias, dn_norm_w, w_branch_attn, w_branch_delta, w_out):
    B, L, _ = h.shape
    hn = rms_norm(h, norm_w)
    proj = hn @ w_in.astype(h.dtype)
    offs = np.cumsum(IN_SIZES)[:-1].tolist()
    aq, ak, av, az, dq, dk, dv, dz, db, da, ga, gd = jnp.split(proj, offs, axis=-1)

    lam_init = 0.8 - 0.6 * math.exp(-0.3 * layer_idx)
    f32 = jnp.float32
    lam = (jnp.exp(jnp.sum(lambda_q1.astype(f32) * lambda_k1.astype(f32)))
           - jnp.exp(jnp.sum(lambda_q2.astype(f32) * lambda_k2.astype(f32))) + lam_init)
    qa = aq.reshape(B, L, ATT_HEADS, 2, ATT_QK_DIM)
    ka = ak.reshape(B, L, ATT_HEADS, 2, ATT_QK_DIM)
    va = av.reshape(B, L, ATT_HEADS, ATT_V_DIM)
    o_a = diff_attention(qa, ka, va, lam)
    o_a = (rms_norm(o_a, attn_norm_w) * (1.0 - lam_init)).reshape(B, L, ATT_WIDTH)
    y_a = (o_a * jax.nn.silu(az)) @ w_branch_attn.astype(h.dtype)

    qkv = jnp.concatenate([dq, dk, dv], axis=-1)
    qkv = jax.nn.silu(causal_depthwise_conv(qkv, conv_w))
    cq, ck, cv = jnp.split(qkv, [DN_KEY_WIDTH, 2 * DN_KEY_WIDTH], axis=-1)
    q = l2_normalize(cq.reshape(B, L, DN_HEADS, DN_K_DIM)) * (DN_K_DIM ** -0.5)
    k = l2_normalize(ck.reshape(B, L, DN_HEADS, DN_K_DIM))
    v = cv.reshape(B, L, DN_HEADS, DN_V_DIM)
    beta = jax.nn.sigmoid(db.astype(f32))
    g = -jnp.exp(a_log.astype(f32)) * jax.nn.softplus(da.astype(f32) + dt_bias.astype(f32))
    pad = (-N_META) % DN_CHUNK

    def pad_front(t):
        return jnp.pad(t, [(0, 0), (pad, 0)] + [(0, 0)] * (t.ndim - 2))

    o_d = gated_delta_chunked(pad_front(q), pad_front(k), pad_front(v), pad_front(beta), pad_front(g))
    o_d = rms_norm(o_d[:, pad:].astype(h.dtype), dn_norm_w).reshape(B, L, DN_WIDTH)
    y_d = (o_d * jax.nn.silu(dz)) @ w_branch_delta.astype(h.dtype)

    merged = jax.nn.sigmoid(ga) * y_a + jax.nn.sigmoid(gd) * y_d
    return merged @ w_out.astype(h.dtype)


def setup_inputs(seed: int = 0) -> dict:
    key = jax.random.key(seed)
    ks = jax.random.split(key, 20)
    nrm = jax.random.normal
    dt = jnp.exp(jax.random.uniform(ks[8], (DEPTH, DN_HEADS)) * (math.log(0.1) - math.log(0.001))
                 + math.log(0.001))
    return {
        'x': nrm(ks[0], (BATCH, SEQ, D_MODEL), jnp.float32),
        'meta_tokens': nrm(ks[1], (N_META, D_MODEL), jnp.float32),
        'norm_w': 1.0 + 0.02 * nrm(ks[2], (DEPTH, D_MODEL), jnp.float32),
        'w_in': nrm(ks[3], (DEPTH, D_MODEL, IN_DIM), jnp.float32) * D_MODEL ** -0.5,
        'lambda_q1': 0.1 * nrm(ks[4], (DEPTH, ATT_QK_DIM), jnp.float32),
        'lambda_k1': 0.1 * nrm(ks[5], (DEPTH, ATT_QK_DIM), jnp.float32),
        'lambda_q2': 0.1 * nrm(ks[6], (DEPTH, ATT_QK_DIM), jnp.float32),
        'lambda_k2': 0.1 * nrm(ks[7], (DEPTH, ATT_QK_DIM), jnp.float32),
        'attn_norm_w': 1.0 + 0.02 * nrm(ks[9], (DEPTH, ATT_V_DIM), jnp.float32),
        'conv_w': nrm(ks[10], (DEPTH, DN_CONV, DN_CONV_CH), jnp.float32) * DN_CONV ** -0.5,
        'a_log': jnp.log(jax.random.uniform(ks[11], (DEPTH, DN_HEADS), jnp.float32, 1.0, 16.0)),
        'dt_bias': dt + jnp.log(-jnp.expm1(-dt)),
        'dn_norm_w': 1.0 + 0.02 * nrm(ks[12], (DEPTH, DN_V_DIM), jnp.float32),
        'w_branch_attn': nrm(ks[13], (DEPTH, ATT_WIDTH, D_MODEL), jnp.float32) * ATT_WIDTH ** -0.5,
        'w_branch_delta': nrm(ks[14], (DEPTH, DN_WIDTH, D_MODEL), jnp.float32) * DN_WIDTH ** -0.5,
        'w_out': nrm(ks[15], (DEPTH, D_MODEL, D_MODEL), jnp.float32) * D_MODEL ** -0.5,
        'final_norm_w': 1.0 + 0.02 * nrm(ks[16], (D_MODEL,), jnp.float32),
    }


def reference(x, meta_tokens, norm_w, w_in, lambda_q1, lambda_k1, lambda_q2, lambda_k2,
              attn_norm_w, conv_w, a_log, dt_bias, dn_norm_w, w_branch_attn, w_branch_delta,
              w_out, final_norm_w):
    B = x.shape[0]
    meta = jnp.broadcast_to(meta_tokens[None].astype(x.dtype), (B, N_META, D_MODEL))
    h = jnp.concatenate([meta, x], axis=1)
    for l in range(DEPTH):
        h = h + hybrid_layer(h, l, norm_w[l], w_in[l], lambda_q1[l], lambda_k1[l], lambda_q2[l],
                             lambda_k2[l], attn_norm_w[l], conv_w[l], a_log[l], dt_bias[l],
                             dn_norm_w[l], w_branch_attn[l], w_branch_delta[l], w_out[l])
    return rms_norm(h, final_norm_w)[:, N_META:]
```

```cpp
#include <hip/hip_runtime.h>
#include <hip/hip_cooperative_groups.h>
#include <stdint.h>
#include <stdio.h>
namespace cg = cooperative_groups;

typedef unsigned short u16;
typedef __attribute__((ext_vector_type(8))) short bf16x8;
typedef __attribute__((ext_vector_type(16))) float f32x16;
typedef __attribute__((ext_vector_type(4))) unsigned u32x4;

constexpr int SEQ = 8192, NMETA = 16, LTOK = 8208, DM = 1024, NTOK = 16416, NX = 16384;
constexpr int LPAD = 8256, NCH = 129, INDIM = 10256;
constexpr float QSCALE = 0.125f * 1.44269504088896f;

constexpr size_t OFF_AQ = 0;
constexpr size_t OFF_AK = 33619968;
constexpr size_t OFF_AVT = 67436544;
constexpr size_t OFF_DX = 101253120;
constexpr size_t OFF_HALO = 202702848;
constexpr size_t OFF_EXTRA = 207458304;
constexpr size_t OFF_W3 = 243388416;
constexpr size_t OFF_BETA = 249679872;
constexpr size_t OFF_G = 250208256;
constexpr size_t OFF_PSQ = 250736640;
constexpr size_t OFF_PSUM = 252850176;
constexpr size_t OFF_CTL = 253898752;
constexpr size_t WS_END = 253902848;
constexpr int SMEM_BYTES = 73728;
constexpr int P2_SPLIT = 24;

struct Params {
  const float* x; const float* meta; const float* norm_w; const float* w_in;
  const float* lq1; const float* lk1; const float* lq2; const float* lk2;
  const float* attn_norm_w; const float* conv_w; const float* a_log; const float* dt_bias;
  const float* dn_norm_w; const float* w_a; const float* w_d; const float* w_o; const float* final_w;
  float* out; unsigned char* ws;
};

typedef __bf16 bf16x2_t __attribute__((ext_vector_type(2)));
typedef float f32x2_t __attribute__((ext_vector_type(2)));
__device__ __forceinline__ unsigned cvtpk(float lo, float hi) { f32x2_t v = {lo, hi}; bf16x2_t b = __builtin_convertvector(v, bf16x2_t); return __builtin_bit_cast(unsigned, b); }
__device__ __forceinline__ u16 f2bf(float f) { return (u16)(cvtpk(f, 0.f) & 0xffffu); }
__device__ __forceinline__ float bf2f(u16 v) { return __uint_as_float(((unsigned)v) << 16); }
__device__ __forceinline__ float bflo(unsigned v) { return __uint_as_float(v << 16); }
__device__ __forceinline__ float bfhi(unsigned v) { return __uint_as_float(v & 0xffff0000u); }
__device__ __forceinline__ float sigmoidf_(float x) { return 1.f / (1.f + __expf(-x)); }
__device__ __forceinline__ float siluf_(float x) { return x / (1.f + __expf(-x)); }
__device__ __forceinline__ f32x16 mfma32(bf16x8 a, bf16x8 b, f32x16 c) { return __builtin_amdgcn_mfma_f32_32x32x16_bf16(a, b, c, 0, 0, 0); }
__device__ __forceinline__ float wave_sum(float v) {
#pragma unroll
  for (int o = 32; o > 0; o >>= 1) v += __shfl_xor(v, o);
  return v;
}

__device__ __forceinline__ int ltid() { int t = threadIdx.x; asm volatile("" : "+v"(t)); return t; }

__device__ __forceinline__ void lds_barrier() { asm volatile("s_waitcnt lgkmcnt(0)\n\ts_barrier" ::: "memory"); }

__device__ __forceinline__ bool tile_map(int i, int xcd, int MT, int NT, int& mt, int& nt) {
  int cm = (MT - xcd + 7) >> 3;
  int ag = i / (8 * NT);
  if (ag * 8 >= cm) return false;
  int gs = cm - ag * 8; if (gs > 8) gs = 8;
  int j = i - ag * 8 * NT;
  if (j >= gs * NT) return false;
  int al = j % gs; nt = j / gs;
  mt = xcd + 8 * (8 * ag + al);
  return true;
}

template <class ARowF, class KOffF>
__device__ __forceinline__ void gemm_kloop(f32x16 (&acc)[2][2], ARowF arow, KOffF koff, const u16* __restrict__ Bt, int m0, int n0, unsigned char* smem) {
  const int tid = ltid(), lane = tid & 63, wave = tid >> 6;
  const int wm = wave >> 1, wn = wave & 1;
  const int lr = tid >> 3, lc = tid & 7;
  const int l31 = lane & 31, hf = lane >> 5;
  u16* sA = (u16*)smem; u16* sB = sA + 2 * 128 * 72;
  const u16* pa0 = arow(m0 + lr) + lc * 8; const u16* pa1 = arow(m0 + lr + 32) + lc * 8;
  const u16* pa2 = arow(m0 + lr + 64) + lc * 8; const u16* pa3 = arow(m0 + lr + 96) + lc * 8;
  const u16* pb0 = Bt + (size_t)(n0 + lr) * 1024 + lc * 8;
  u32x4 ra0, ra1, ra2, ra3, rb0, rb1, rb2, rb3;
  {
    const size_t ko = koff(0);
    ra0 = *(const u32x4*)(pa0 + ko); ra1 = *(const u32x4*)(pa1 + ko); ra2 = *(const u32x4*)(pa2 + ko); ra3 = *(const u32x4*)(pa3 + ko);
    rb0 = *(const u32x4*)(pb0); rb1 = *(const u32x4*)(pb0 + 32 * 1024); rb2 = *(const u32x4*)(pb0 + 64 * 1024); rb3 = *(const u32x4*)(pb0 + 96 * 1024);
  }
  u16* wA0 = sA + lr * 72 + lc * 8; u16* wB0 = sB + lr * 72 + lc * 8;
  *(u32x4*)(wA0) = ra0; *(u32x4*)(wA0 + 32 * 72) = ra1; *(u32x4*)(wA0 + 64 * 72) = ra2; *(u32x4*)(wA0 + 96 * 72) = ra3;
  *(u32x4*)(wB0) = rb0; *(u32x4*)(wB0 + 32 * 72) = rb1; *(u32x4*)(wB0 + 64 * 72) = rb2; *(u32x4*)(wB0 + 96 * 72) = rb3;
  lds_barrier();
#pragma unroll 1
  for (int kt = 0; kt < 16; ++kt) {
    const int buf = kt & 1;
    if (kt + 1 < 16) {
      const size_t ko = koff((kt + 1) * 64); const int kb = (kt + 1) * 64;
      ra0 = *(const u32x4*)(pa0 + ko); ra1 = *(const u32x4*)(pa1 + ko); ra2 = *(const u32x4*)(pa2 + ko); ra3 = *(const u32x4*)(pa3 + ko);
      rb0 = *(const u32x4*)(pb0 + kb); rb1 = *(const u32x4*)(pb0 + 32 * 1024 + kb); rb2 = *(const u32x4*)(pb0 + 64 * 1024 + kb); rb3 = *(const u32x4*)(pb0 + 96 * 1024 + kb);
    }
    const u16* cA = sA + buf * 128 * 72 + (wm * 64 + l31) * 72 + hf * 8;
    const u16* cB = sB + buf * 128 * 72 + (wn * 64 + l31) * 72 + hf * 8;
#pragma unroll
    for (int ks = 0; ks < 4; ++ks) {
      bf16x8 a0 = *(const bf16x8*)(cA + ks * 16);
      bf16x8 a1 = *(const bf16x8*)(cA + 32 * 72 + ks * 16);
      bf16x8 b0 = *(const bf16x8*)(cB + ks * 16);
      bf16x8 b1 = *(const bf16x8*)(cB + 32 * 72 + ks * 16);
      acc[0][0] = mfma32(a0, b0, acc[0][0]);
      acc[0][1] = mfma32(a0, b1, acc[0][1]);
      acc[1][0] = mfma32(a1, b0, acc[1][0]);
      acc[1][1] = mfma32(a1, b1, acc[1][1]);
    }
    if (kt + 1 < 16) {
      u16* wA = wA0 + (buf ^ 1) * 128 * 72; u16* wB = wB0 + (buf ^ 1) * 128 * 72;
      *(u32x4*)(wA) = ra0; *(u32x4*)(wA + 32 * 72) = ra1; *(u32x4*)(wA + 64 * 72) = ra2; *(u32x4*)(wA + 96 * 72) = ra3;
      *(u32x4*)(wB) = rb0; *(u32x4*)(wB + 32 * 72) = rb1; *(u32x4*)(wB + 64 * 72) = rb2; *(u32x4*)(wB + 96 * 72) = rb3;
    }
    lds_barrier();
  }
}

__device__ __forceinline__ void stage_acc(f32x16 (&acc)[2][2], float* sC) {
  const int tid__ = ltid(); const int lane = tid__ & 63, wave = tid__ >> 6;
  const int wm = wave >> 1, wn = wave & 1, l31 = lane & 31, hf = lane >> 5;
  float* base = sC + (wm * 64 + 4 * hf) * 132 + wn * 64 + l31;
#pragma unroll
  for (int mi = 0; mi < 2; ++mi)
#pragma unroll
    for (int ni = 0; ni < 2; ++ni)
#pragma unroll
      for (int r = 0; r < 16; ++r) base[(mi * 32 + 8 * (r >> 2) + (r & 3)) * 132 + ni * 32] = acc[mi][ni][r];
  __syncthreads();
}
template <class Epi>
__device__ __forceinline__ void epilogue_rows(f32x16 (&acc)[2][2], int m0, int n0, unsigned char* smem, Epi epi) {
  float* sC = (float*)smem;
  stage_acc(acc, sC);
  const int tid = ltid();
#pragma unroll 2
  for (int it = 0; it < 8; ++it) {
    int idx = tid + 256 * it; int r = idx >> 4, c8 = (idx & 15) * 8;
    float4 a = *(const float4*)(sC + r * 132 + c8), b = *(const float4*)(sC + r * 132 + c8 + 4);
    epi(m0 + r, n0 + c8, a, b);
  }
  __syncthreads();
}
template <class Epi>
__device__ __forceinline__ void epilogue_cols(f32x16 (&acc)[2][2], int m0, int n0, unsigned char* smem, Epi epi) {
  float* sC = (float*)smem;
  stage_acc(acc, sC);
  const int tid = ltid();
#pragma unroll 2
  for (int it = 0; it < 8; ++it) {
    int idx = tid + 256 * it; int n = idx & 127, r8 = (idx >> 7) * 8;
    const float* s = sC + r8 * 132 + n;
    float4 a = make_float4(s[0], s[132], s[264], s[396]), b = make_float4(s[528], s[660], s[792], s[924]);
    epi(m0 + r8, n0 + n, a, b);
  }
  __syncthreads();
}
__device__ __forceinline__ uint4 pack8(float4 a, float4 b) { uint4 o; o.x = cvtpk(a.x, a.y); o.y = cvtpk(a.z, a.w); o.z = cvtpk(b.x, b.y); o.w = cvtpk(b.z, b.w); return o; }

__device__ __forceinline__ void zero_acc(f32x16 (&acc)[2][2]) {
#pragma unroll
  for (int a = 0; a < 2; ++a)
#pragma unroll
    for (int b = 0; b < 2; ++b)
#pragma unroll
      for (int r = 0; r < 16; ++r) acc[a][b][r] = 0.f;
}

__device__ __forceinline__ void phase0(const Params& p, unsigned char* smem) {
  u16* hn = (u16*)p.out; u16* wtin = hn + (size_t)NTOK * DM;
  u16* w3 = (u16*)(p.ws + OFF_W3);
  const int tid = ltid(), lane = tid & 63, wave = tid >> 6;
  constexpr int N_HN = NTOK / 4;
  constexpr int NT_IN = 161;
  constexpr int N_TR = 16 * NT_IN + 3 * 256;
  constexpr int N_MISC = 16;
  for (int it = blockIdx.x; it < N_HN + N_TR + N_MISC; it += gridDim.x) {
    if (it < N_HN) {
      int row = it * 4 + wave; int b = row / LTOK, pos = row - b * LTOK;
      const float* src = pos < NMETA ? p.meta + pos * DM : p.x + ((size_t)b * SEQ + pos - NMETA) * DM;
      float4 v[4]; float ss = 0.f;
#pragma unroll
      for (int i = 0; i < 4; ++i) { v[i] = ((const float4*)src)[lane + 64 * i]; ss += v[i].x * v[i].x + v[i].y * v[i].y + v[i].z * v[i].z + v[i].w * v[i].w; }
      ss = wave_sum(ss);
      float rs = rsqrtf(ss * (1.f / 1024.f) + 1e-6f);
#pragma unroll
      for (int i = 0; i < 4; ++i) {
        float4 w = ((const float4*)p.norm_w)[lane + 64 * i];
        uint2 o; o.x = cvtpk(v[i].x * rs * w.x, v[i].y * rs * w.y); o.y = cvtpk(v[i].z * rs * w.z, v[i].w * rs * w.w);
        ((uint2*)(hn + (size_t)row * DM))[lane + 64 * i] = o;
      }
    } else if (it < N_HN + N_TR) {
      int j = it - N_HN; const float* W; u16* Wt; int N, kt, nt;
      if (j < 16 * NT_IN) { W = p.w_in; Wt = wtin; N = INDIM; kt = j / NT_IN; nt = j - kt * NT_IN; }
      else { j -= 16 * NT_IN; int mtx = j >> 8; j &= 255; W = mtx == 0 ? p.w_a : (mtx == 1 ? p.w_d : p.w_o); Wt = w3 + (size_t)mtx * 1024 * 1024; N = 1024; kt = j >> 4; nt = j & 15; }
      float* tile = (float*)smem;
#pragma unroll
      for (int i = 0; i < 16; ++i) {
        int k = (tid >> 6) + 4 * i; int n = nt * 64 + (tid & 63);
        tile[k * 65 + (tid & 63)] = n < N ? W[(size_t)(kt * 64 + k) * N + n] : 0.f;
      }
      __syncthreads();
      int kk2 = (tid & 31) * 2;
#pragma unroll
      for (int i = 0; i < 8; ++i) {
        int jj = (tid >> 5) + 8 * i; int n = nt * 64 + jj;
        if (n < N) *(unsigned*)(Wt + (size_t)n * 1024 + kt * 64 + kk2) = cvtpk(tile[kk2 * 65 + jj], tile[(kk2 + 1) * 65 + jj]);
      }
      __syncthreads();
    } else {
      int mi = it - N_HN - N_TR;
      unsigned* ak = (unsigned*)(p.ws + OFF_AK); unsigned* avt = (unsigned*)(p.ws + OFF_AVT);
      for (int idx = mi * 256 + tid; idx < 2 * 48 * 512; idx += N_MISC * 256) {
        int b = idx / (48 * 512), r = idx - b * 48 * 512;
        ak[((size_t)b * LPAD + LTOK) * 512 + r] = 0u;
      }
      for (int idx = mi * 256 + tid; idx < 2048 * 24; idx += N_MISC * 256) {
        int row = idx / 24, c = idx - row * 24;
        avt[(size_t)row * (LPAD / 2) + LTOK / 2 + c] = 0u;
      }
      if (mi == 0) {
        int* ctl = (int*)(p.ws + OFF_CTL);
        if (tid < 16) ctl[tid] = 0;
        if (wave == 1) {
          float a = p.lq1[lane] * p.lk1[lane], c = p.lq2[lane] * p.lk2[lane];
          a = wave_sum(a); c = wave_sum(c);
          if (lane == 0) ((float*)ctl)[16] = __expf(a) - __expf(c) + 0.2f;
        }
      }
    }
  }
}

__device__ __forceinline__ void phase1(const Params& p, unsigned char* smem) {
  const u16* hn = (const u16*)p.out; const u16* wtin = hn + (size_t)NTOK * DM;
  u16* AQ = (u16*)(p.ws + OFF_AQ); u16* AK = (u16*)(p.ws + OFF_AK); u16* AVT = (u16*)(p.ws + OFF_AVT);
  u16* DX = (u16*)(p.ws + OFF_DX); u16* HALO = (u16*)(p.ws + OFF_HALO);
  float* BETA = (float*)(p.ws + OFF_BETA); float* GG = (float*)(p.ws + OFF_G);
  const int xcd = blockIdx.x & 7, lw = blockIdx.x >> 3, LW = (gridDim.x - xcd + 7) >> 3;
  for (int i = lw;; i += LW) {
    int mt, nt; if (!tile_map(i, xcd, 129, 49, mt, nt)) break;
    const int m0 = mt * 128;
    const int n0 = nt < 24 ? nt * 128 : (nt < 48 ? 4096 + (nt - 24) * 128 : 8192);
    f32x16 acc[2][2]; zero_acc(acc);
    gemm_kloop(acc, [&](int m) { int mm = m < NTOK ? m : NTOK - 1; return hn + (size_t)mm * DM; }, [](int k0) { return (size_t)k0; }, wtin, m0, n0, smem);
    if (nt < 8) {
      epilogue_rows(acc, m0, n0, smem, [&](int m, int n, float4 a, float4 b) {
        if (m < NTOK) {
          a.x *= QSCALE; a.y *= QSCALE; a.z *= QSCALE; a.w *= QSCALE; b.x *= QSCALE; b.y *= QSCALE; b.z *= QSCALE; b.w *= QSCALE;
          *(uint4*)(AQ + (size_t)m * 1024 + n) = pack8(a, b);
        }
      });
    } else if (nt < 16) {
      epilogue_rows(acc, m0, n0, smem, [&](int m, int n, float4 a, float4 b) {
        if (m < NTOK) { int bb = m / LTOK, pos = m - bb * LTOK; *(uint4*)(AK + ((size_t)bb * LPAD + pos) * 1024 + (n - 1024)) = pack8(a, b); }
      });
    } else if (nt < 24) {
      epilogue_cols(acc, m0, n0, smem, [&](int m, int n, float4 a, float4 b) {
        if (m < NTOK) { int bb = m / LTOK, pos = m - bb * LTOK; *(uint4*)(AVT + ((size_t)(bb * 1024 + (n - 2048))) * LPAD + pos) = pack8(a, b); }
      });
    } else if (nt < 48) {
      epilogue_rows(acc, m0, n0, smem, [&](int m, int n, float4 a, float4 b) {
        if (m < NTOK) {
          int nn = n - 4096; int which = nn >> 10; int h = (nn >> 7) & 7; int d = nn & 127;
          int bb = m / LTOK, pos = m - bb * LTOK; int pp = pos + 48; int c = pp >> 6, rr = pp & 63;
          size_t blk = ((size_t)((bb * 8 + h) * NCH + c)) * 3 + which;
          uint4 o = pack8(a, b);
          *(uint4*)(DX + blk * 8192 + rr * 128 + d) = o;
          if (rr >= 61) *(uint4*)(HALO + blk * 384 + (rr - 61) * 128 + d) = o;
        }
      });
    } else {
      epilogue_rows(acc, m0, n0, smem, [&](int m, int n, float4 a, float4 b) {
        if (m < NTOK && n < 8208) {
          int isg = n >= 8200;
          int bb = m / LTOK, pos = m - bb * LTOK;
          float v[8] = {a.x, a.y, a.z, a.w, b.x, b.y, b.z, b.w};
#pragma unroll
          for (int h = 0; h < 8; ++h) {
            size_t o = (size_t)(bb * 8 + h) * LPAD + pos + 48;
            if (!isg) BETA[o] = sigmoidf_(v[h]);
            else { float z = v[h] + p.dt_bias[h]; float sp = z > 20.f ? z : log1pf(__expf(z)); GG[o] = -__expf(p.a_log[h]) * sp; }
          }
        }
      });
    }
  }
}

__device__ __forceinline__ void phase2(const Params& p, unsigned char* smem, const int lo, const int hi, const int worker, const int nworkers) {
  u16* DX = (u16*)(p.ws + OFF_DX); const u16* HALO = (const u16*)(p.ws + OFF_HALO);
  const float* BETA = (const float*)(p.ws + OFF_BETA); const float* GG = (const float*)(p.ws + OFF_G);
  u16* TA = (u16*)(p.ws + OFF_EXTRA);
  float* sin = (float*)smem;
  u16* sq = (u16*)(smem + 34304);
  u16* sk = sq + 64 * 136;
  u16* svT = sq;
  float* sgc = (float*)(smem + 34304 + 34816);
  float* sbeta = sgc + 64;
  float* sM = (float*)smem;
  const int tid = ltid(), lane = tid & 63, wave = tid >> 6;
  const int l31 = lane & 31, hf = lane >> 5;
  for (int idx2 = lo + worker; idx2 < hi; idx2 += nworkers) {
    const int bh = idx2 & 15, c = idx2 >> 4; const int it = bh * NCH + c; const int h = bh & 7;
    if (wave == 0) {
      const bool pad = (c == 0 && lane < 48);
      float g = pad ? 0.f : GG[(size_t)bh * LPAD + c * 64 + lane];
      float be = pad ? 0.f : BETA[(size_t)bh * LPAD + c * 64 + lane];
#pragma unroll
      for (int o = 1; o < 64; o <<= 1) { float t = __shfl_up(g, o); if (lane >= o) g += t; }
      sgc[lane] = g; sbeta[lane] = be;
    }
    for (int wi = 0; wi < 3; ++wi) {
      const int which = wi == 0 ? 2 : wi - 1;
      u16* X = DX + ((size_t)it * 3 + which) * 8192;
      const u16* H = HALO + ((size_t)(it - 1) * 3 + which) * 384;
      {
        u32x4 ld[5];
#pragma unroll
        for (int i = 0; i < 5; ++i) {
          const int idx = tid + 256 * i; const int rr = idx >> 4, c8 = (idx & 15) * 8; const int r = rr - 3;
          const bool zero = (idx >= 67 * 16) || (c == 0 && r < 48);
          const u16* srcp = (r < 0) ? (H + rr * 128 + c8) : (X + r * 128 + c8);
          u32x4 z = {0u, 0u, 0u, 0u};
          ld[i] = zero ? z : *(const u32x4*)srcp;
        }
#pragma unroll
        for (int i = 0; i < 5; ++i) {
          const int idx = tid + 256 * i; const int rr = idx >> 4, c8 = (idx & 15) * 8;
          if (idx < 67 * 16) {
            float4 a = make_float4(bflo(ld[i].x), bfhi(ld[i].x), bflo(ld[i].y), bfhi(ld[i].y));
            float4 b = make_float4(bflo(ld[i].z), bfhi(ld[i].z), bflo(ld[i].w), bfhi(ld[i].w));
            *(float4*)(sin + rr * 128 + c8) = a; *(float4*)(sin + rr * 128 + c8 + 4) = b;
          }
        }
      }
      __syncthreads();
      const int d0 = 2 * lane; const int ch = which * 1024 + h * 128 + d0;
      float w0[4], w1[4];
#pragma unroll
      for (int j = 0; j < 4; ++j) { w0[j] = p.conv_w[j * 3072 + ch]; w1[j] = p.conv_w[j * 3072 + ch + 1]; }
      for (int rb = 0; rb < 4; ++rb) {
        float y0[4], y1[4];
#pragma unroll
        for (int u = 0; u < 4; ++u) {
          const int r = wave * 16 + rb * 4 + u;
          float a0 = 0.f, a1 = 0.f;
#pragma unroll
          for (int j = 0; j < 4; ++j) { float2 xv = *(const float2*)(sin + (r + j) * 128 + d0); a0 += w0[j] * xv.x; a1 += w1[j] * xv.y; }
          y0[u] = siluf_(a0); y1[u] = siluf_(a1);
        }
        if (which < 2) {
          float ss[4];
#pragma unroll
          for (int u = 0; u < 4; ++u) ss[u] = y0[u] * y0[u] + y1[u] * y1[u];
#pragma unroll
          for (int o = 32; o > 0; o >>= 1) {
#pragma unroll
            for (int u = 0; u < 4; ++u) ss[u] += __shfl_xor(ss[u], o);
          }
#pragma unroll
          for (int u = 0; u < 4; ++u) {
            const int r = wave * 16 + rb * 4 + u;
            const bool pad = (c == 0 && r < 48);
            float sc = rsqrtf(ss[u] + 1e-6f) * (which == 0 ? 0.08838834764831845f : 1.f);
            if (pad) sc = 0.f;
            unsigned pk = cvtpk(y0[u] * sc, y1[u] * sc);
            *(unsigned*)(X + r * 128 + d0) = pk;
            *(unsigned*)((which == 0 ? sq : sk) + r * 136 + d0) = pk;
          }
        } else {
#pragma unroll
          for (int u = 0; u < 4; ++u) {
            const int r = wave * 16 + rb * 4 + u;
            const bool pad = (c == 0 && r < 48);
            float be = pad ? 0.f : sbeta[r];
            svT[d0 * 72 + r] = f2bf(y0[u] * be); svT[(d0 + 1) * 72 + r] = f2bf(y1[u] * be);
          }
        }
      }
      __syncthreads();
      if (which == 2) {
#pragma unroll
        for (int i = 0; i < 4; ++i) { int idx = tid + 256 * i; int e = idx >> 3, c8 = (idx & 7) * 8; *(uint4*)(X + e * 64 + c8) = *(const uint4*)(svT + e * 72 + c8); }
      }
    }
    const int ti = wave >> 1, tj = wave & 1;
    f32x16 kk, qk;
#pragma unroll
    for (int r = 0; r < 16; ++r) { kk[r] = 0.f; qk[r] = 0.f; }
#pragma unroll
    for (int s = 0; s < 8; ++s) {
      bf16x8 bj = *(const bf16x8*)(sk + (32 * tj + l31) * 136 + s * 16 + hf * 8);
      bf16x8 ak = *(const bf16x8*)(sk + (32 * ti + l31) * 136 + s * 16 + hf * 8);
      bf16x8 aq = *(const bf16x8*)(sq + (32 * ti + l31) * 136 + s * 16 + hf * 8);
      kk = mfma32(ak, bj, kk); qk = mfma32(aq, bj, qk);
    }
    __syncthreads();
    u16* Tg = TA + (size_t)it * 8704; u16* Ag = Tg + 4096; float* SCg = (float*)(Tg + 8192);
    {
      const int j = 32 * tj + l31; const float gcj = sgc[j];
#pragma unroll
      for (int r = 0; r < 16; ++r) {
        const int i = 32 * ti + 8 * (r >> 2) + 4 * hf + (r & 3);
        const float gci = sgc[i]; const float bi = sbeta[i];
        const float dec = __expf(gci - gcj);
        sM[i * 68 + j] = (j < i) ? bi * kk[r] * dec : 0.f;
        Ag[i * 64 + j] = f2bf((j <= i) ? qk[r] * dec : 0.f);
      }
    }
    __syncthreads();
    float* sTc = (float*)sq;
    if (wave == 0) {
      float* mycol = sTc + lane * 68;
#pragma unroll 1
      for (int blk = 0; blk < 4; ++blk) {
        const int r0 = blk * 16;
        float acc[16];
#pragma unroll
        for (int r = 0; r < 16; ++r) acc[r] = 0.f;
#pragma unroll 1
        for (int j = 0; j < r0; j += 4) {
          const float4 t4 = *(const float4*)(mycol + j);
#pragma unroll
          for (int r = 0; r < 16; ++r) {
            const float4 m4 = *(const float4*)(sM + (r0 + r) * 68 + j);
            acc[r] += (m4.x * t4.x + m4.y * t4.y) + (m4.z * t4.z + m4.w * t4.w);
          }
        }
        float tt[16];
#pragma unroll
        for (int r = 0; r < 16; ++r) {
          float s = acc[r];
#pragma unroll
          for (int q4 = 0; q4 < r; q4 += 4) {
            const float4 m4 = *(const float4*)(sM + (r0 + r) * 68 + r0 + q4);
            s += m4.x * tt[q4];
            if (q4 + 1 < r) s += m4.y * tt[q4 + 1];
            if (q4 + 2 < r) s += m4.z * tt[q4 + 2];
            if (q4 + 3 < r) s += m4.w * tt[q4 + 3];
          }
          tt[r] = ((r0 + r == lane) ? 1.f : 0.f) - s;
        }
#pragma unroll
        for (int r = 0; r < 16; r += 4) *(float4*)(mycol + r0 + r) = make_float4(tt[r], tt[r + 1], tt[r + 2], tt[r + 3]);
      }
    }
    __syncthreads();
#pragma unroll
    for (int i = 0; i < 2; ++i) {
      int idx = tid + 256 * i; int r = idx >> 3, c8 = (idx & 7) * 8; const float* s = sTc + c8 * 68 + r;
      uint4 o; o.x = cvtpk(s[0], s[68]); o.y = cvtpk(s[136], s[204]); o.z = cvtpk(s[272], s[340]); o.w = cvtpk(s[408], s[476]);
      *(uint4*)(Tg + r * 64 + c8) = o;
    }
    if (tid < 64) {
      float gc = sgc[tid], be = sbeta[tid]; float eg = __expf(gc);
      SCg[tid] = be; SCg[64 + tid] = be * eg; SCg[128 + tid] = eg; SCg[192 + tid] = __expf(sgc[63] - gc);
    }
    __syncthreads();
  }
}

__device__ __forceinline__ bf16x8 mk8(uint2 lo, uint2 hi) { u32x4 t = {lo.x, lo.y, hi.x, hi.y}; return __builtin_bit_cast(bf16x8, t); }

__device__ __forceinline__ void scan_chunked(const Params& p, unsigned char* smem, int bh, f32x16 (&S)[4], const int c_begin, const int c_end) {
  u16* DX = (u16*)(p.ws + OFF_DX); const u16* TA = (const u16*)(p.ws + OFF_EXTRA);
  const int tid = ltid(), lane = tid & 63, wave = tid >> 6;
  const int l31 = lane & 31, hf = lane >> 5;
  u16* sk = (u16*)smem;
  u16* sq = sk + 64 * 136;
  u16* sT = sq + 64 * 136;
  u16* sA = sT + 64 * 72;
  float* sSC = (float*)(sA + 64 * 72);
  u32x4 pk[4], pq[4], pT[2], pA[2]; uint2 pv[8]; float psc;
#pragma unroll 1
  for (int c = c_begin; c < c_end; ++c) {
    {
      const u16* Xq = DX + ((size_t)(bh * NCH + c) * 3) * 8192; const u16* Xk = Xq + 8192; const u16* Xv = Xk + 8192;
      const u16* Tg = TA + (size_t)(bh * NCH + c) * 8704; const u16* Ag = Tg + 4096;
#pragma unroll
      for (int i = 0; i < 4; ++i) { pk[i] = *(const u32x4*)(Xk + (tid + 256 * i) * 8); pq[i] = *(const u32x4*)(Xq + (tid + 256 * i) * 8); }
#pragma unroll
      for (int i = 0; i < 2; ++i) { pT[i] = *(const u32x4*)(Tg + (tid + 256 * i) * 8); pA[i] = *(const u32x4*)(Ag + (tid + 256 * i) * 8); }
      psc = ((const float*)(Tg + 8192))[tid];
#pragma unroll
      for (int i = 0; i < 8; ++i) pv[i] = *(const uint2*)(Xv + (wave * 32 + l31) * 64 + 32 * (i >> 2) + 8 * (i & 3) + 4 * hf);
    }
#pragma unroll
    for (int i = 0; i < 4; ++i) {
      int idx = tid + 256 * i; int row = idx >> 4, ch = idx & 15; const int po = (ch >> 1) * 16 + (ch & 1) * 4;
      u16* dk = sk + row * 136 + po; *(uint2*)dk = make_uint2(pk[i].x, pk[i].y); *(uint2*)(dk + 8) = make_uint2(pk[i].z, pk[i].w);
      u16* dq = sq + row * 136 + po; *(uint2*)dq = make_uint2(pq[i].x, pq[i].y); *(uint2*)(dq + 8) = make_uint2(pq[i].z, pq[i].w);
    }
#pragma unroll
    for (int i = 0; i < 2; ++i) {
      int idx = tid + 256 * i; int row = idx >> 3, ch = idx & 7; const int po = (ch >> 1) * 16 + (ch & 1) * 4;
      u16* dt = sT + row * 72 + po; *(uint2*)dt = make_uint2(pT[i].x, pT[i].y); *(uint2*)(dt + 8) = make_uint2(pT[i].z, pT[i].w);
      u16* da = sA + row * 72 + po; *(uint2*)da = make_uint2(pA[i].x, pA[i].y); *(uint2*)(da + 8) = make_uint2(pA[i].z, pA[i].w);
    }
    sSC[tid] = psc;
    lds_barrier();
    __builtin_amdgcn_sched_barrier(0);
    u32x4 yf[4];
#pragma unroll
    for (int mt = 0; mt < 2; ++mt) {
      f32x16 x;
#pragma unroll
      for (int r = 0; r < 16; ++r) x[r] = 0.f;
#pragma unroll
      for (int dt = 0; dt < 4; ++dt)
#pragma unroll
        for (int s = 0; s < 2; ++s) {
          const bf16x8 kfr = *(const bf16x8*)(sk + (32 * mt + l31) * 136 + 32 * dt + 16 * s + 8 * hf);
          u32x4 sb = {cvtpk(S[dt][8 * s + 0], S[dt][8 * s + 1]), cvtpk(S[dt][8 * s + 2], S[dt][8 * s + 3]), cvtpk(S[dt][8 * s + 4], S[dt][8 * s + 5]), cvtpk(S[dt][8 * s + 6], S[dt][8 * s + 7])};
          x = mfma32(kfr, __builtin_bit_cast(bf16x8, sb), x);
        }
#pragma unroll
      for (int g = 0; g < 4; ++g) {
        float4 bg4 = *(const float4*)(sSC + 64 + 32 * mt + 8 * g + 4 * hf);
        uint2 vb = pv[mt * 4 + g];
        float y0 = bflo(vb.x) - bg4.x * x[4 * g + 0], y1 = bfhi(vb.x) - bg4.y * x[4 * g + 1];
        float y2 = bflo(vb.y) - bg4.z * x[4 * g + 2], y3 = bfhi(vb.y) - bg4.w * x[4 * g + 3];
        yf[2 * mt + (g >> 1)][(g & 1) * 2 + 0] = cvtpk(y0, y1);
        yf[2 * mt + (g >> 1)][(g & 1) * 2 + 1] = cvtpk(y2, y3);
      }
      __builtin_amdgcn_sched_barrier(0);
    }
    __builtin_amdgcn_sched_barrier(0);
    __builtin_amdgcn_sched_barrier(0);
    u32x4 vnf[4];
#pragma unroll
    for (int mt = 0; mt < 2; ++mt) {
      f32x16 vn;
#pragma unroll
      for (int r = 0; r < 16; ++r) vn[r] = 0.f;
#pragma unroll
      for (int s = 0; s < 4; ++s) {
        const bf16x8 tfr = *(const bf16x8*)(sT + (32 * mt + l31) * 72 + 16 * s + 8 * hf);
        vn = mfma32(tfr, __builtin_bit_cast(bf16x8, yf[s]), vn);
      }
#pragma unroll
      for (int g = 0; g < 4; ++g) {
        vnf[2 * mt + (g >> 1)][(g & 1) * 2 + 0] = cvtpk(vn[4 * g + 0], vn[4 * g + 1]);
        vnf[2 * mt + (g >> 1)][(g & 1) * 2 + 1] = cvtpk(vn[4 * g + 2], vn[4 * g + 3]);
      }
    }
    __builtin_amdgcn_sched_barrier(0);
    u16* Oq = DX + ((size_t)(bh * NCH + c) * 3) * 8192;
#pragma unroll
    for (int mt = 0; mt < 2; ++mt) {
      f32x16 o;
#pragma unroll
      for (int r = 0; r < 16; ++r) o[r] = 0.f;
#pragma unroll
      for (int dt = 0; dt < 4; ++dt)
#pragma unroll
        for (int s = 0; s < 2; ++s) {
          const bf16x8 qfr = *(const bf16x8*)(sq + (32 * mt + l31) * 136 + 32 * dt + 16 * s + 8 * hf);
          u32x4 sb = {cvtpk(S[dt][8 * s + 0], S[dt][8 * s + 1]), cvtpk(S[dt][8 * s + 2], S[dt][8 * s + 3]), cvtpk(S[dt][8 * s + 4], S[dt][8 * s + 5]), cvtpk(S[dt][8 * s + 6], S[dt][8 * s + 7])};
          o = mfma32(qfr, __builtin_bit_cast(bf16x8, sb), o);
        }
#pragma unroll
      for (int g = 0; g < 4; ++g) {
        float4 eg4 = *(const float4*)(sSC + 128 + 32 * mt + 8 * g + 4 * hf);
        o[4 * g + 0] *= eg4.x; o[4 * g + 1] *= eg4.y; o[4 * g + 2] *= eg4.z; o[4 * g + 3] *= eg4.w;
      }
#pragma unroll
      for (int s = 0; s < 4; ++s) {
        const bf16x8 afr = *(const bf16x8*)(sA + (32 * mt + l31) * 72 + 16 * s + 8 * hf);
        o = mfma32(afr, __builtin_bit_cast(bf16x8, vnf[s]), o);
      }
#pragma unroll
      for (int r = 0; r < 16; ++r) Oq[(32 * mt + 8 * (r >> 2) + 4 * hf + (r & 3)) * 128 + wave * 32 + l31] = f2bf(o[r]);
      __builtin_amdgcn_sched_barrier(0);
    }
    __builtin_amdgcn_sched_barrier(0);
    const float cd = sSC[128 + 63];
#pragma unroll
    for (int dt = 0; dt < 4; ++dt)
#pragma unroll
      for (int r = 0; r < 16; ++r) S[dt][r] *= cd;
    u32x4 vs[4];
#pragma unroll
    for (int s = 0; s < 4; ++s) {
      const float4 e0 = *(const float4*)(sSC + 192 + 16 * s + 4 * hf), e1 = *(const float4*)(sSC + 192 + 16 * s + 8 + 4 * hf);
      vs[s].x = cvtpk(bflo(vnf[s].x) * e0.x, bfhi(vnf[s].x) * e0.y); vs[s].y = cvtpk(bflo(vnf[s].y) * e0.z, bfhi(vnf[s].y) * e0.w);
      vs[s].z = cvtpk(bflo(vnf[s].z) * e1.x, bfhi(vnf[s].z) * e1.y); vs[s].w = cvtpk(bflo(vnf[s].w) * e1.z, bfhi(vnf[s].w) * e1.w);
    }
    {
      u32x4 id1 = {0u, 0u, 0u, 0u}, id2 = {0u, 0u, 0u, 0u};
      {
        const int l15 = l31 & 15;
        const int jsel = (((l15 >> 2) & 1) == hf) ? (4 * (l15 >> 3) + (l15 & 3)) : -1;
        const int j1 = (l31 < 16) ? jsel : -1;
        const int j2 = (l31 >= 16) ? jsel : -1;
        const unsigned one_lo = 0x3f80u, one_hi = 0x3f800000u;
#pragma unroll
        for (int w = 0; w < 4; ++w) {
          id1[w] = (j1 == 2 * w) ? one_lo : ((j1 == 2 * w + 1) ? one_hi : 0u);
          id2[w] = (j2 == 2 * w) ? one_lo : ((j2 == 2 * w + 1) ? one_hi : 0u);
        }
      }
      const bf16x8 B1 = __builtin_bit_cast(bf16x8, id1), B2 = __builtin_bit_cast(bf16x8, id2);
#pragma unroll
      for (int dt = 0; dt < 4; ++dt)
#pragma unroll
        for (int mt = 0; mt < 2; ++mt) {
          f32x16 kt;
#pragma unroll
          for (int r = 0; r < 16; ++r) kt[r] = 0.f;
          const u16* k0 = sk + (32 * mt + l31) * 136 + 32 * dt + 8 * hf;
          kt = mfma32(*(const bf16x8*)(k0), B1, kt);
          kt = mfma32(*(const bf16x8*)(k0 + 16), B2, kt);
#pragma unroll
          for (int s2 = 0; s2 < 2; ++s2) {
            u32x4 af = {cvtpk(kt[8 * s2 + 0], kt[8 * s2 + 1]), cvtpk(kt[8 * s2 + 2], kt[8 * s2 + 3]), cvtpk(kt[8 * s2 + 4], kt[8 * s2 + 5]), cvtpk(kt[8 * s2 + 6], kt[8 * s2 + 7])};
            S[dt] = mfma32(__builtin_bit_cast(bf16x8, af), __builtin_bit_cast(bf16x8, vs[2 * mt + s2]), S[dt]);
          }
        }
    }
    lds_barrier();
  }
}

__device__ __forceinline__ void attn_item(const Params& p, unsigned char* smem, int b, int h, int qb, float lam) {
  int tid_ = ltid();
  const int tid = tid_, lane = tid & 63, wave = tid >> 6;
  const int l31 = lane & 31, hf = lane >> 5;
  const int map = wave >> 1, r0 = (wave & 1) * 32;
  u16* AQ = (u16*)(p.ws + OFF_AQ); const u16* AK = (const u16*)(p.ws + OFF_AK); const u16* AVT = (const u16*)(p.ws + OFF_AVT);
  u16* sK = (u16*)smem;
  float* sO = (float*)smem;
  const int t0 = qb * 64; const int ntiles = qb + 2;
  const size_t qrow = (size_t)(b * LTOK + NMETA + t0 + r0 + l31);
  bf16x8 qf[4];
#pragma unroll
  for (int s = 0; s < 4; ++s) qf[s] = *(const bf16x8*)(AQ + qrow * 1024 + h * 128 + map * 64 + s * 16 + hf * 8);
  f32x16 oacc[4];
#pragma unroll
  for (int d = 0; d < 4; ++d)
#pragma unroll
    for (int r = 0; r < 16; ++r) oacc[d][r] = 0.f;
  float m_run = -1e30f, l_run = 0.f;
  const int qpos = NMETA + t0 + r0 + l31;
  const u16* kbase = AK + ((size_t)b * LPAD) * 1024 + h * 128;
  const u16* vbase = AVT + ((size_t)(b * 8 + h) * 128) * LPAD;
  const int kc = tid & 15, kr = tid >> 4;
  const int vc = tid & 7, vr = tid >> 3;
  u32x4 ak[4], av[4], bk[4], bv[4];
  auto gload = [&](u32x4 (&rk)[4], u32x4 (&rv)[4], int kt) {
#pragma unroll
    for (int i = 0; i < 4; ++i) {
      rk[i] = *(const u32x4*)(kbase + (size_t)(kt * 64 + kr + 16 * i) * 1024 + kc * 8);
      rv[i] = *(const u32x4*)(vbase + (size_t)(vr + 32 * i) * LPAD + kt * 64 + vc * 8);
    }
  };
  auto swrite = [&](const u32x4 (&rk)[4], const u32x4 (&rv)[4], int buf) {
    u16* bK = sK + buf * 17920; u16* bV = bK + 64 * 136;
#pragma unroll
    for (int i = 0; i < 4; ++i) {
      *(u32x4*)(bK + (kr + 16 * i) * 136 + kc * 8) = rk[i];
      u16* dst = bV + (vr + 32 * i) * 72 + (vc >> 1) * 16 + (vc & 1) * 4;
      *(uint2*)dst = make_uint2(rv[i].x, rv[i].y); *(uint2*)(dst + 8) = make_uint2(rv[i].z, rv[i].w);
    }
  };
  auto compute = [&](int kt, int buf) {
    const u16* bK = sK + buf * 17920; const u16* bV = bK + 64 * 136;
    f32x16 st[2];
#pragma unroll
    for (int mt = 0; mt < 2; ++mt) {
#pragma unroll
      for (int r = 0; r < 16; ++r) st[mt][r] = 0.f;
#pragma unroll
      for (int s = 0; s < 4; ++s) {
        bf16x8 kf = *(const bf16x8*)(bK + (mt * 32 + l31) * 136 + map * 64 + s * 16 + hf * 8);
        st[mt] = mfma32(kf, qf[s], st[mt]);
      }
    }
    if (kt >= ntiles - 2) {
#pragma unroll
      for (int mt = 0; mt < 2; ++mt)
#pragma unroll
        for (int r = 0; r < 16; ++r) {
          int key = kt * 64 + mt * 32 + 8 * (r >> 2) + 4 * hf + (r & 3);
          if (key > qpos) st[mt][r] = -1e30f;
        }
    }
    float mx = -1e30f;
#pragma unroll
    for (int mt = 0; mt < 2; ++mt)
#pragma unroll
      for (int r = 0; r < 16; ++r) mx = fmaxf(mx, st[mt][r]);
    mx = fmaxf(mx, __shfl_xor(mx, 32));
    const float m_new = fmaxf(m_run, mx);
    const float alpha = __builtin_amdgcn_exp2f(m_run - m_new);
    float rsum = 0.f;
#pragma unroll
    for (int mt = 0; mt < 2; ++mt)
#pragma unroll
      for (int r = 0; r < 16; ++r) { float pv = __builtin_amdgcn_exp2f(st[mt][r] - m_new); st[mt][r] = pv; rsum += pv; }
    l_run = l_run * alpha + rsum; m_run = m_new;
#pragma unroll
    for (int d = 0; d < 4; ++d)
#pragma unroll
      for (int r = 0; r < 16; ++r) oacc[d][r] *= alpha;
#pragma unroll
    for (int s = 0; s < 4; ++s) {
      const int mt = s >> 1, ss = s & 1;
      u32x4 pt = {cvtpk(st[mt][8 * ss + 0], st[mt][8 * ss + 1]), cvtpk(st[mt][8 * ss + 2], st[mt][8 * ss + 3]),
                  cvtpk(st[mt][8 * ss + 4], st[mt][8 * ss + 5]), cvtpk(st[mt][8 * ss + 6], st[mt][8 * ss + 7])};
      bf16x8 pf = __builtin_bit_cast(bf16x8, pt);
#pragma unroll
      for (int d = 0; d < 4; ++d) {
        const bf16x8 vf = *(const bf16x8*)(bV + (d * 32 + l31) * 72 + mt * 32 + ss * 16 + hf * 8);
        oacc[d] = mfma32(vf, pf, oacc[d]);
      }
    }
  };
  gload(ak, av, 0); swrite(ak, av, 0); gload(bk, bv, 1);
  lds_barrier();
#pragma unroll 1
  for (int kt = 0; kt < ntiles; kt += 2) {
    if (kt + 2 < ntiles) gload(ak, av, kt + 2);
    compute(kt, 0);
    if (kt + 1 < ntiles) swrite(bk, bv, 1);
    lds_barrier();
    if (kt + 1 < ntiles) {
      if (kt + 3 < ntiles) gload(bk, bv, kt + 3);
      compute(kt + 1, 1);
      if (kt + 2 < ntiles) swrite(ak, av, 0);
      lds_barrier();
    }
  }
  const float l_tot = l_run + __shfl_xor(l_run, 32);
  const float inv = 1.f / l_tot;
#pragma unroll
  for (int d = 0; d < 4; ++d)
#pragma unroll
    for (int g = 0; g < 4; ++g) {
      float4 o4 = make_float4(oacc[d][4 * g] * inv, oacc[d][4 * g + 1] * inv, oacc[d][4 * g + 2] * inv, oacc[d][4 * g + 3] * inv);
      *(float4*)(sO + ((map * 64 + r0 + l31) * 132 + d * 32 + 8 * g + 4 * hf)) = o4;
    }
  __syncthreads();
  {
    const int q = tid >> 2, qq = tid & 3;
    const float4* o0 = (const float4*)(sO + (q * 132 + qq * 32)); const float4* o1 = (const float4*)(sO + ((64 + q) * 132 + qq * 32));
    float ss = 0.f;
#pragma unroll
    for (int i = 0; i < 8; ++i) {
      float4 a = o0[i], c = o1[i];
      float dx = a.x - lam * c.x, dy = a.y - lam * c.y, dz = a.z - lam * c.z, dw = a.w - lam * c.w;
      ss += dx * dx + dy * dy + dz * dz + dw * dw;
    }
    ss += __shfl_xor(ss, 1); ss += __shfl_xor(ss, 2);
    const float rsn = rsqrtf(ss * (1.f / 128.f) + 1e-6f) * 0.8f;
    const float4* nw = (const float4*)(p.attn_norm_w + qq * 32);
    uint4* dst = (uint4*)(AQ + (size_t)(b * LTOK + NMETA + t0 + q) * 1024 + h * 128 + qq * 32);
#pragma unroll
    for (int i = 0; i < 4; ++i) {
      float4 a0 = o0[2 * i], c0 = o1[2 * i], a1 = o0[2 * i + 1], c1 = o1[2 * i + 1];
      float4 w0 = nw[2 * i], w1 = nw[2 * i + 1];
      uint4 o;
      o.x = cvtpk((a0.x - lam * c0.x) * rsn * w0.x, (a0.y - lam * c0.y) * rsn * w0.y);
      o.y = cvtpk((a0.z - lam * c0.z) * rsn * w0.z, (a0.w - lam * c0.w) * rsn * w0.w);
      o.z = cvtpk((a1.x - lam * c1.x) * rsn * w1.x, (a1.y - lam * c1.y) * rsn * w1.y);
      o.w = cvtpk((a1.z - lam * c1.z) * rsn * w1.z, (a1.w - lam * c1.w) * rsn * w1.w);
      dst[i] = o;
    }
  }
  __syncthreads();
}

__device__ __forceinline__ void phase3(const Params& p, unsigned char* smem) {
  __shared__ int s_item;
  const int tid = ltid();
  const bool is_scan = (blockIdx.x < 16);
  float* ssave = (float*)(p.ws + OFF_PSQ) + ((size_t)blockIdx.x * 256 + tid) * 64;
  if (is_scan) {
    f32x16 S[4];
#pragma unroll
    for (int d = 0; d < 4; ++d)
#pragma unroll
      for (int r = 0; r < 16; ++r) S[d][r] = 0.f;
    scan_chunked(p, smem, blockIdx.x, S, 0, P2_SPLIT);
#pragma unroll
    for (int d = 0; d < 4; ++d)
#pragma unroll
      for (int r = 0; r < 16; r += 4) *(float4*)(ssave + d * 16 + r) = make_float4(S[d][r], S[d][r + 1], S[d][r + 2], S[d][r + 3]);
  } else {
    phase2(p, smem, P2_SPLIT * 16, NCH * 16, blockIdx.x - 16, gridDim.x - 16);
  }
  cg::this_grid().sync();
  if (is_scan) {
    f32x16 S[4];
#pragma unroll
    for (int d = 0; d < 4; ++d)
#pragma unroll
      for (int r = 0; r < 16; r += 4) { float4 v = *(const float4*)(ssave + d * 16 + r); S[d][r] = v.x; S[d][r + 1] = v.y; S[d][r + 2] = v.z; S[d][r + 3] = v.w; }
    scan_chunked(p, smem, blockIdx.x, S, P2_SPLIT, NCH);
  }
  int* cnt = (int*)(p.ws + OFF_CTL);
  const float lam = ((const float*)(p.ws + OFF_CTL))[16];
  const int myq = blockIdx.x & 7;
  for (int qq = 0; qq < 8; ++qq) {
    const int q = (myq + qq) & 7;
    while (true) {
      if (tid == 0) s_item = atomicAdd(&cnt[q], 1);
      __syncthreads();
      const int idx = s_item;
      __syncthreads();
      if (idx >= 256) break;
      attn_item(p, smem, idx & 1, q, 127 - (idx >> 1), lam);
    }
  }
}

__device__ __forceinline__ int tokrow_of(int m) { int b = m >> 13; return b * LTOK + NMETA + (m & 8191); }

__device__ __forceinline__ void phase4(const Params& p, unsigned char* smem) {
  const u16* hn = (const u16*)p.out; const u16* wtin = hn + (size_t)NTOK * DM;
  u16* AQ = (u16*)(p.ws + OFF_AQ); u16* DX = (u16*)(p.ws + OFF_DX);
  u16* SGA = (u16*)(p.ws + OFF_AK); u16* SGD = (u16*)(p.ws + OFF_AVT);
  const int xcd = blockIdx.x & 7, lw = blockIdx.x >> 3, LW = (gridDim.x - xcd + 7) >> 3;
  for (int i = lw;; i += LW) {
    int mt, nt; if (!tile_map(i, xcd, 128, 32, mt, nt)) break;
    const int m0 = mt * 128;
    const int n0 = nt < 8 ? 3072 + nt * 128 : (nt < 16 ? 7168 + (nt - 8) * 128 : 8208 + (nt - 16) * 128);
    f32x16 acc[2][2]; zero_acc(acc);
    gemm_kloop(acc, [&](int m) { return hn + (size_t)tokrow_of(m) * DM; }, [](int k0) { return (size_t)k0; }, wtin, m0, n0, smem);
    if (nt < 8) {
      epilogue_rows(acc, m0, n0, smem, [&](int m, int n, float4 a, float4 b) {
        uint4* ptr = (uint4*)(AQ + (size_t)tokrow_of(m) * 1024 + (n - 3072));
        uint4 o = *ptr;
        a.x = bflo(o.x) * siluf_(a.x); a.y = bfhi(o.x) * siluf_(a.y); a.z = bflo(o.y) * siluf_(a.z); a.w = bfhi(o.y) * siluf_(a.w);
        b.x = bflo(o.z) * siluf_(b.x); b.y = bfhi(o.z) * siluf_(b.y); b.z = bflo(o.w) * siluf_(b.z); b.w = bfhi(o.w) * siluf_(b.w);
        *ptr = pack8(a, b);
      });
    } else if (nt < 16) {
      epilogue_rows(acc, m0, n0, smem, [&](int m, int n, float4 a, float4 b) {
        int col = n - 7168; int h = col >> 7, d = col & 127;
        int bb = m >> 13, t = m & 8191; int bh = bb * 8 + h; int pp = t + 64;
        uint4* ptr = (uint4*)(DX + (((size_t)(bh * NCH + (pp >> 6))) * 3) * 8192 + (pp & 63) * 128 + d);
        uint4 o = *ptr;
        float o0 = bflo(o.x), o1 = bfhi(o.x), o2 = bflo(o.y), o3 = bfhi(o.y), o4 = bflo(o.z), o5 = bfhi(o.z), o6 = bflo(o.w), o7 = bfhi(o.w);
        float sq = o0 * o0 + o1 * o1 + o2 * o2 + o3 * o3 + o4 * o4 + o5 * o5 + o6 * o6 + o7 * o7;
        sq += __shfl_xor(sq, 1); sq += __shfl_xor(sq, 2); sq += __shfl_xor(sq, 4); sq += __shfl_xor(sq, 8);
        float rs = rsqrtf(sq * (1.f / 128.f) + 1e-6f);
        float4 w0 = *(const float4*)(p.dn_norm_w + d), w1 = *(const float4*)(p.dn_norm_w + d + 4);
        a.x = o0 * rs * w0.x * siluf_(a.x); a.y = o1 * rs * w0.y * siluf_(a.y); a.z = o2 * rs * w0.z * siluf_(a.z); a.w = o3 * rs * w0.w * siluf_(a.w);
        b.x = o4 * rs * w1.x * siluf_(b.x); b.y = o5 * rs * w1.y * siluf_(b.y); b.z = o6 * rs * w1.z * siluf_(b.z); b.w = o7 * rs * w1.w * siluf_(b.w);
        *ptr = pack8(a, b);
      });
    } else {
      epilogue_rows(acc, m0, n0, smem, [&](int m, int n, float4 a, float4 b) {
        int col = n - 8208; u16* dst = col < 1024 ? SGA + col : SGD + (col - 1024);
        a.x = sigmoidf_(a.x); a.y = sigmoidf_(a.y); a.z = sigmoidf_(a.z); a.w = sigmoidf_(a.w);
        b.x = sigmoidf_(b.x); b.y = sigmoidf_(b.y); b.z = sigmoidf_(b.z); b.w = sigmoidf_(b.w);
        *(uint4*)(dst + (size_t)m * 1024) = pack8(a, b);
      });
    }
  }
}

__device__ __forceinline__ void phase5(const Params& p, unsigned char* smem) {
  const u16* AQ = (const u16*)(p.ws + OFF_AQ); const u16* DX = (const u16*)(p.ws + OFF_DX);
  const u16* SGA = (const u16*)(p.ws + OFF_AK); const u16* SGD = (const u16*)(p.ws + OFF_AVT);
  const u16* wat = (const u16*)(p.ws + OFF_W3); const u16* wdt = wat + 1024 * 1024;
  u16* MERGED = (u16*)(p.ws + OFF_EXTRA);
  const int xcd = blockIdx.x & 7, lw = blockIdx.x >> 3, LW = (gridDim.x - xcd + 7) >> 3;
  for (int i = lw;; i += LW) {
    int mt, nt; if (!tile_map(i, xcd, 128, 8, mt, nt)) break;
    const int m0 = mt * 128, n0 = nt * 128;
    f32x16 acc[2][2]; zero_acc(acc);
    gemm_kloop(acc, [&](int m) { return AQ + (size_t)tokrow_of(m) * 1024; }, [](int k0) { return (size_t)k0; }, wat, m0, n0, smem);
    epilogue_rows(acc, m0, n0, smem, [&](int m, int n, float4 a, float4 b) {
      uint4 g = *(const uint4*)(SGA + (size_t)m * 1024 + n);
      a.x *= bflo(g.x); a.y *= bfhi(g.x); a.z *= bflo(g.y); a.w *= bfhi(g.y); b.x *= bflo(g.z); b.y *= bfhi(g.z); b.z *= bflo(g.w); b.w *= bfhi(g.w);
      *(uint4*)(MERGED + (size_t)m * 1024 + n) = pack8(a, b);
    });
  }
  for (int i = lw;; i += LW) {
    int mt, nt; if (!tile_map(i, xcd, 128, 8, mt, nt)) break;
    const int m0 = mt * 128, n0 = nt * 128;
    f32x16 acc[2][2]; zero_acc(acc);
    gemm_kloop(acc, [&](int m) {
      int bb = m >> 13, t = m & 8191; int pp = t + 64;
      return DX + (((size_t)((bb * 8) * NCH + (pp >> 6))) * 3) * 8192 + (pp & 63) * 128;
    }, [](int k0) { return (size_t)(k0 >> 7) * ((size_t)NCH * 3 * 8192) + (size_t)(k0 & 127); }, wdt, m0, n0, smem);
    epilogue_rows(acc, m0, n0, smem, [&](int m, int n, float4 a, float4 b) {
      uint4 g = *(const uint4*)(SGD + (size_t)m * 1024 + n);
      uint4* ptr = (uint4*)(MERGED + (size_t)m * 1024 + n);
      uint4 o = *ptr;
      a.x = bflo(o.x) + a.x * bflo(g.x); a.y = bfhi(o.x) + a.y * bfhi(g.x); a.z = bflo(o.y) + a.z * bflo(g.y); a.w = bfhi(o.y) + a.w * bfhi(g.y);
      b.x = bflo(o.z) + b.x * bflo(g.z); b.y = bfhi(o.z) + b.y * bfhi(g.z); b.z = bflo(o.w) + b.z * bflo(g.w); b.w = bfhi(o.w) + b.w * bfhi(g.w);
      *ptr = pack8(a, b);
    });
  }
}

__device__ __forceinline__ void phase6(const Params& p, unsigned char* smem) {
  const u16* MERGED = (const u16*)(p.ws + OFF_EXTRA);
  const u16* wot = (const u16*)(p.ws + OFF_W3) + 2 * 1024 * 1024;
  float* PSUM = (float*)(p.ws + OFF_PSUM);
  const int xcd = blockIdx.x & 7, lw = blockIdx.x >> 3, LW = (gridDim.x - xcd + 7) >> 3;
  for (int i = lw;; i += LW) {
    int mt, nt; if (!tile_map(i, xcd, 128, 8, mt, nt)) break;
    const int m0 = mt * 128, n0 = nt * 128;
    f32x16 acc[2][2]; zero_acc(acc);
    gemm_kloop(acc, [&](int m) { return MERGED + (size_t)m * 1024; }, [](int k0) { return (size_t)k0; }, wot, m0, n0, smem);
    epilogue_rows(acc, m0, n0, smem, [&](int m, int n, float4 a, float4 b) {
      const float4* xp = (const float4*)(p.x + (size_t)m * 1024 + n);
      float4 x0 = xp[0], x1 = xp[1];
      a.x += x0.x; a.y += x0.y; a.z += x0.z; a.w += x0.w; b.x += x1.x; b.y += x1.y; b.z += x1.z; b.w += x1.w;
      float4* op = (float4*)(p.out + (size_t)m * 1024 + n);
      op[0] = a; op[1] = b;
      float sq = a.x * a.x + a.y * a.y + a.z * a.z + a.w * a.w + b.x * b.x + b.y * b.y + b.z * b.z + b.w * b.w;
      sq += __shfl_xor(sq, 1); sq += __shfl_xor(sq, 2); sq += __shfl_xor(sq, 4); sq += __shfl_xor(sq, 8);
      if ((ltid() & 15) == 0) PSUM[(size_t)nt * NX + m] = sq;
    });
  }
}

__device__ __forceinline__ void phase7(const Params& p) {
  const float* PSUM = (const float*)(p.ws + OFF_PSUM);
  const int tid__ = ltid(); const int lane = tid__ & 63, wave = tid__ >> 6;
  for (int it = blockIdx.x; it < NX / 4; it += gridDim.x) {
    int row = it * 4 + wave;
    float tot = 0.f;
#pragma unroll
    for (int j = 0; j < 8; ++j) tot += PSUM[(size_t)j * NX + row];
    float rs = rsqrtf(tot * (1.f / 1024.f) + 1e-6f);
    float4* o = (float4*)(p.out + (size_t)row * 1024);
#pragma unroll
    for (int i = 0; i < 4; ++i) {
      float4 v = o[lane + 64 * i]; float4 w = ((const float4*)p.final_w)[lane + 64 * i];
      v.x *= rs * w.x; v.y *= rs * w.y; v.z *= rs * w.z; v.w *= rs * w.w;
      o[lane + 64 * i] = v;
    }
  }
}

__global__ void __launch_bounds__(256, 2) mega(Params p) {
  extern __shared__ __attribute__((aligned(16))) unsigned char smem[];
  cg::grid_group grid = cg::this_grid();
  phase0(p, smem); grid.sync();
  phase1(p, smem); grid.sync();
  phase2(p, smem, 0, P2_SPLIT * 16, blockIdx.x, gridDim.x); grid.sync();
  phase3(p, smem); grid.sync();
  phase4(p, smem); grid.sync();
  phase5(p, smem); grid.sync();
  phase6(p, smem); grid.sync();
  phase7(p);
}

extern "C" void kernel_launch(void* const* d_in, const int* in_sizes, int n_in, void* d_out, int out_size, void* d_ws, size_t ws_size, hipStream_t stream) {
  static int grid_blocks = 0;
  if (!grid_blocks) {
    int dev = 0, cus = 0, per_cu = 0;
    hipGetDevice(&dev);
    hipDeviceGetAttribute(&cus, hipDeviceAttributeMultiprocessorCount, dev);
    hipFuncSetAttribute((const void*)mega, hipFuncAttributeMaxDynamicSharedMemorySize, SMEM_BYTES);
    hipOccupancyMaxActiveBlocksPerMultiprocessor(&per_cu, (const void*)mega, 256, SMEM_BYTES);
    if (per_cu < 1) per_cu = 1;
    if (per_cu > 2) per_cu = 2;
    grid_blocks = cus * per_cu;
    if (ws_size < WS_END) fprintf(stderr, "workspace too small: %zu < %zu\n", ws_size, (size_t)WS_END);
  }
  Params p{};
  p.x = (const float*)d_in[0]; p.meta = (const float*)d_in[1]; p.norm_w = (const float*)d_in[2]; p.w_in = (const float*)d_in[3];
  p.lq1 = (const float*)d_in[4]; p.lk1 = (const float*)d_in[5]; p.lq2 = (const float*)d_in[6]; p.lk2 = (const float*)d_in[7];
  p.attn_norm_w = (const float*)d_in[8]; p.conv_w = (const float*)d_in[9]; p.a_log = (const float*)d_in[10]; p.dt_bias = (const float*)d_in[11];
  p.dn_norm_w = (const float*)d_in[12]; p.w_a = (const float*)d_in[13]; p.w_d = (const float*)d_in[14]; p.w_o = (const float*)d_in[15]; p.final_w = (const float*)d_in[16];
  p.out = (float*)d_out; p.ws = (unsigned char*)d_ws;
  void* args[] = {&p};
  hipError_t e = hipLaunchCooperativeKernel((const void*)mega, dim3(grid_blocks), dim3(256), args, SMEM_BYTES, stream);
  if (e != hipSuccess) fprintf(stderr, "cooperative launch failed: %s (grid %d)\n", hipGetErrorString(e), grid_blocks);
}
```

```cpp
#include <hip/hip_runtime.h>
#include <hip/hip_cooperative_groups.h>
#include <stdint.h>
#include <stdio.h>
namespace cg = cooperative_groups;

typedef unsigned short u16;
typedef __attribute__((ext_vector_type(8))) short bf16x8;
typedef __attribute__((ext_vector_type(16))) float f32x16;
typedef __attribute__((ext_vector_type(4))) unsigned u32x4;

constexpr int SEQ = 8192, NMETA = 16, LTOK = 8208, DM = 1024, NTOK = 16416, NX = 16384;
constexpr int LPAD = 8256, NCH = 129, INDIM = 10256;
constexpr float QSCALE = 0.125f * 1.44269504088896f;

constexpr size_t OFF_AQ = 0;
constexpr size_t OFF_AK = 33619968;
constexpr size_t OFF_AVT = 67436544;
constexpr size_t OFF_DX = 101253120;
constexpr size_t OFF_HALO = 202702848;
constexpr size_t OFF_EXTRA = 207458304;
constexpr size_t OFF_W3 = 243388416;
constexpr size_t OFF_BETA = 249679872;
constexpr size_t OFF_G = 250208256;
constexpr size_t OFF_PSQ = 250736640;
constexpr size_t OFF_PSUM = 252850176;
constexpr size_t OFF_CTL = 253898752;
constexpr size_t WS_END = 253902848;
constexpr int SMEM_BYTES = 73728;
constexpr int P2_SPLIT = 24;

struct Params {
  const float* x; const float* meta; const float* norm_w; const float* w_in;
  const float* lq1; const float* lk1; const float* lq2; const float* lk2;
  const float* attn_norm_w; const float* conv_w; const float* a_log; const float* dt_bias;
  const float* dn_norm_w; const float* w_a; const float* w_d; const float* w_o; const float* final_w;
  float* out; unsigned char* ws;
};

typedef __bf16 bf16x2_t __attribute__((ext_vector_type(2)));
typedef float f32x2_t __attribute__((ext_vector_type(2)));
__device__ __forceinline__ unsigned cvtpk(float lo, float hi) { f32x2_t v = {lo, hi}; bf16x2_t b = __builtin_convertvector(v, bf16x2_t); return __builtin_bit_cast(unsigned, b); }
__device__ __forceinline__ u16 f2bf(float f) { return (u16)(cvtpk(f, 0.f) & 0xffffu); }
__device__ __forceinline__ float bf2f(u16 v) { return __uint_as_float(((unsigned)v) << 16); }
__device__ __forceinline__ float bflo(unsigned v) { return __uint_as_float(v << 16); }
__device__ __forceinline__ float bfhi(unsigned v) { return __uint_as_float(v & 0xffff0000u); }
__device__ __forceinline__ float sigmoidf_(float x) { return 1.f / (1.f + __expf(-x)); }
__device__ __forceinline__ float siluf_(float x) { return x / (1.f + __expf(-x)); }
__device__ __forceinline__ f32x16 mfma32(bf16x8 a, bf16x8 b, f32x16 c) { return __builtin_amdgcn_mfma_f32_32x32x16_bf16(a, b, c, 0, 0, 0); }
__device__ __forceinline__ float wave_sum(float v) {
#pragma unroll
  for (int o = 32; o > 0; o >>= 1) v += __shfl_xor(v, o);
  return v;
}

__device__ __forceinline__ int ltid() { int t = threadIdx.x; asm volatile("" : "+v"(t)); return t; }

__device__ __forceinline__ void lds_barrier() { asm volatile("s_waitcnt lgkmcnt(0)\n\ts_barrier" ::: "memory"); }

__device__ __forceinline__ bool tile_map(int i, int xcd, int MT, int NT, int& mt, int& nt) {
  int cm = (MT - xcd + 7) >> 3;
  int ag = i / (8 * NT);
  if (ag * 8 >= cm) return false;
  int gs = cm - ag * 8; if (gs > 8) gs = 8;
  int j = i - ag * 8 * NT;
  if (j >= gs * NT) return false;
  int al = j % gs; nt = j / gs;
  mt = xcd + 8 * (8 * ag + al);
  return true;
}

template <class ARowF, class KOffF>
__device__ __forceinline__ void gemm_kloop(f32x16 (&acc)[2][2], ARowF arow, KOffF koff, const u16* __restrict__ Bt, int m0, int n0, unsigned char* smem) {
  const int tid = ltid(), lane = tid & 63, wave = tid >> 6;
  const int wm = wave >> 1, wn = wave & 1;
  const int lr = tid >> 3, lc = tid & 7;
  const int l31 = lane & 31, hf = lane >> 5;
  u16* sA = (u16*)smem; u16* sB = sA + 2 * 128 * 72;
  const u16* pa0 = arow(m0 + lr) + lc * 8; const u16* pa1 = arow(m0 + lr + 32) + lc * 8;
  const u16* pa2 = arow(m0 + lr + 64) + lc * 8; const u16* pa3 = arow(m0 + lr + 96) + lc * 8;
  const u16* pb0 = Bt + (size_t)(n0 + lr) * 1024 + lc * 8;
  u32x4 ra0, ra1, ra2, ra3, rb0, rb1, rb2, rb3;
  {
    const size_t ko = koff(0);
    ra0 = *(const u32x4*)(pa0 + ko); ra1 = *(const u32x4*)(pa1 + ko); ra2 = *(const u32x4*)(pa2 + ko); ra3 = *(const u32x4*)(pa3 + ko);
    rb0 = *(const u32x4*)(pb0); rb1 = *(const u32x4*)(pb0 + 32 * 1024); rb2 = *(const u32x4*)(pb0 + 64 * 1024); rb3 = *(const u32x4*)(pb0 + 96 * 1024);
  }
  u16* wA0 = sA + lr * 72 + lc * 8; u16* wB0 = sB + lr * 72 + lc * 8;
  *(u32x4*)(wA0) = ra0; *(u32x4*)(wA0 + 32 * 72) = ra1; *(u32x4*)(wA0 + 64 * 72) = ra2; *(u32x4*)(wA0 + 96 * 72) = ra3;
  *(u32x4*)(wB0) = rb0; *(u32x4*)(wB0 + 32 * 72) = rb1; *(u32x4*)(wB0 + 64 * 72) = rb2; *(u32x4*)(wB0 + 96 * 72) = rb3;
  lds_barrier();
#pragma unroll 1
  for (int kt = 0; kt < 16; ++kt) {
    const int buf = kt & 1;
    if (kt + 1 < 16) {
      const size_t ko = koff((kt + 1) * 64); const int kb = (kt + 1) * 64;
      ra0 = *(const u32x4*)(pa0 + ko); ra1 = *(const u32x4*)(pa1 + ko); ra2 = *(const u32x4*)(pa2 + ko); ra3 = *(const u32x4*)(pa3 + ko);
      rb0 = *(const u32x4*)(pb0 + kb); rb1 = *(const u32x4*)(pb0 + 32 * 1024 + kb); rb2 = *(const u32x4*)(pb0 + 64 * 1024 + kb); rb3 = *(const u32x4*)(pb0 + 96 * 1024 + kb);
    }
    const u16* cA = sA + buf * 128 * 72 + (wm * 64 + l31) * 72 + hf * 8;
    const u16* cB = sB + buf * 128 * 72 + (wn * 64 + l31) * 72 + hf * 8;
#pragma unroll
    for (int ks = 0; ks < 4; ++ks) {
      bf16x8 a0 = *(const bf16x8*)(cA + ks * 16);
      bf16x8 a1 = *(const bf16x8*)(cA + 32 * 72 + ks * 16);
      bf16x8 b0 = *(const bf16x8*)(cB + ks * 16);
      bf16x8 b1 = *(const bf16x8*)(cB + 32 * 72 + ks * 16);
      acc[0][0] = mfma32(a0, b0, acc[0][0]);
      acc[0][1] = mfma32(a0, b1, acc[0][1]);
      acc[1][0] = mfma32(a1, b0, acc[1][0]);
      acc[1][1] = mfma32(a1, b1, acc[1][1]);
    }
    if (kt + 1 < 16) {
      u16* wA = wA0 + (buf ^ 1) * 128 * 72; u16* wB = wB0 + (buf ^ 1) * 128 * 72;
      *(u32x4*)(wA) = ra0; *(u32x4*)(wA + 32 * 72) = ra1; *(u32x4*)(wA + 64 * 72) = ra2; *(u32x4*)(wA + 96 * 72) = ra3;
      *(u32x4*)(wB) = rb0; *(u32x4*)(wB + 32 * 72) = rb1; *(u32x4*)(wB + 64 * 72) = rb2; *(u32x4*)(wB + 96 * 72) = rb3;
    }
    lds_barrier();
  }
}

__device__ __forceinline__ void stage_acc(f32x16 (&acc)[2][2], float* sC) {
  const int tid__ = ltid(); const int lane = tid__ & 63, wave = tid__ >> 6;
  const int wm = wave >> 1, wn = wave & 1, l31 = lane & 31, hf = lane >> 5;
  float* base = sC + (wm * 64 + 4 * hf) * 132 + wn * 64 + l31;
#pragma unroll
  for (int mi = 0; mi < 2; ++mi)
#pragma unroll
    for (int ni = 0; ni < 2; ++ni)
#pragma unroll
      for (int r = 0; r < 16; ++r) base[(mi * 32 + 8 * (r >> 2) + (r & 3)) * 132 + ni * 32] = acc[mi][ni][r];
  __syncthreads();
}
template <class Epi>
__device__ __forceinline__ void epilogue_rows(f32x16 (&acc)[2][2], int m0, int n0, unsigned char* smem, Epi epi) {
  float* sC = (float*)smem;
  stage_acc(acc, sC);
  const int tid = ltid();
#pragma unroll 2
  for (int it = 0; it < 8; ++it) {
    int idx = tid + 256 * it; int r = idx >> 4, c8 = (idx & 15) * 8;
    float4 a = *(const float4*)(sC + r * 132 + c8), b = *(const float4*)(sC + r * 132 + c8 + 4);
    epi(m0 + r, n0 + c8, a, b);
  }
  __syncthreads();
}
template <class Epi>
__device__ __forceinline__ void epilogue_cols(f32x16 (&acc)[2][2], int m0, int n0, unsigned char* smem, Epi epi) {
  float* sC = (float*)smem;
  stage_acc(acc, sC);
  const int tid = ltid();
#pragma unroll 2
  for (int it = 0; it < 8; ++it) {
    int idx = tid + 256 * it; int n = idx & 127, r8 = (idx >> 7) * 8;
    const float* s = sC + r8 * 132 + n;
    float4 a = make_float4(s[0], s[132], s[264], s[396]), b = make_float4(s[528], s[660], s[792], s[924]);
    epi(m0 + r8, n0 + n, a, b);
  }
  __syncthreads();
}
__device__ __forceinline__ uint4 pack8(float4 a, float4 b) { uint4 o; o.x = cvtpk(a.x, a.y); o.y = cvtpk(a.z, a.w); o.z = cvtpk(b.x, b.y); o.w = cvtpk(b.z, b.w); return o; }

__device__ __forceinline__ void zero_acc(f32x16 (&acc)[2][2]) {
#pragma unroll
  for (int a = 0; a < 2; ++a)
#pragma unroll
    for (int b = 0; b < 2; ++b)
#pragma unroll
      for (int r = 0; r < 16; ++r) acc[a][b][r] = 0.f;
}

__device__ __forceinline__ void phase0(const Params& p, unsigned char* smem) {
  u16* hn = (u16*)p.out; u16* wtin = hn + (size_t)NTOK * DM;
  u16* w3 = (u16*)(p.ws + OFF_W3);
  const int tid = ltid(), lane = tid & 63, wave = tid >> 6;
  constexpr int N_HN = NTOK / 4;
  constexpr int NT_IN = 161;
  constexpr int N_TR = 16 * NT_IN + 3 * 256;
  constexpr int N_MISC = 16;
  for (int it = blockIdx.x; it < N_HN + N_TR + N_MISC; it += gridDim.x) {
    if (it < N_HN) {
      int row = it * 4 + wave; int b = row / LTOK, pos = row - b * LTOK;
      const float* src = pos < NMETA ? p.meta + pos * DM : p.x + ((size_t)b * SEQ + pos - NMETA) * DM;
      float4 v[4]; float ss = 0.f;
#pragma unroll
      for (int i = 0; i < 4; ++i) { v[i] = ((const float4*)src)[lane + 64 * i]; ss += v[i].x * v[i].x + v[i].y * v[i].y + v[i].z * v[i].z + v[i].w * v[i].w; }
      ss = wave_sum(ss);
      float rs = rsqrtf(ss * (1.f / 1024.f) + 1e-6f);
#pragma unroll
      for (int i = 0; i < 4; ++i) {
        float4 w = ((const float4*)p.norm_w)[lane + 64 * i];
        uint2 o; o.x = cvtpk(v[i].x * rs * w.x, v[i].y * rs * w.y); o.y = cvtpk(v[i].z * rs * w.z, v[i].w * rs * w.w);
        ((uint2*)(hn + (size_t)row * DM))[lane + 64 * i] = o;
      }
    } else if (it < N_HN + N_TR) {
      int j = it - N_HN; const float* W; u16* Wt; int N, kt, nt;
      if (j < 16 * NT_IN) { W = p.w_in; Wt = wtin; N = INDIM; kt = j / NT_IN; nt = j - kt * NT_IN; }
      else { j -= 16 * NT_IN; int mtx = j >> 8; j &= 255; W = mtx == 0 ? p.w_a : (mtx == 1 ? p.w_d : p.w_o); Wt = w3 + (size_t)mtx * 1024 * 1024; N = 1024; kt = j >> 4; nt = j & 15; }
      float* tile = (float*)smem;
#pragma unroll
      for (int i = 0; i < 16; ++i) {
        int k = (tid >> 6) + 4 * i; int n = nt * 64 + (tid & 63);
        tile[k * 65 + (tid & 63)] = n < N ? W[(size_t)(kt * 64 + k) * N + n] : 0.f;
      }
      __syncthreads();
      int kk2 = (tid & 31) * 2;
#pragma unroll
      for (int i = 0; i < 8; ++i) {
        int jj = (tid >> 5) + 8 * i; int n = nt * 64 + jj;
        if (n < N) *(unsigned*)(Wt + (size_t)n * 1024 + kt * 64 + kk2) = cvtpk(tile[kk2 * 65 + jj], tile[(kk2 + 1) * 65 + jj]);
      }
      __syncthreads();
    } else {
      int mi = it - N_HN - N_TR;
      unsigned* ak = (unsigned*)(p.ws + OFF_AK); unsigned* avt = (unsigned*)(p.ws + OFF_AVT);
      for (int idx = mi * 256 + tid; idx < 2 * 48 * 512; idx += N_MISC * 256) {
        int b = idx / (48 * 512), r = idx - b * 48 * 512;
        ak[((size_t)b * LPAD + LTOK) * 512 + r] = 0u;
      }
      for (int idx = mi * 256 + tid; idx < 2048 * 24; idx += N_MISC * 256) {
        int row = idx / 24, c = idx - row * 24;
        avt[(size_t)row * (LPAD / 2) + LTOK / 2 + c] = 0u;
      }
      if (mi == 0) {
        int* ctl = (int*)(p.ws + OFF_CTL);
        if (tid < 16) ctl[tid] = 0;
        if (wave == 1) {
          float a = p.lq1[lane] * p.lk1[lane], c = p.lq2[lane] * p.lk2[lane];
          a = wave_sum(a); c = wave_sum(c);
          if (lane == 0) ((float*)ctl)[16] = __expf(a) - __expf(c) + 0.2f;
        }
      }
    }
  }
}

__device__ __forceinline__ void phase1(const Params& p, unsigned char* smem) {
  const u16* hn = (const u16*)p.out; const u16* wtin = hn + (size_t)NTOK * DM;
  u16* AQ = (u16*)(p.ws + OFF_AQ); u16* AK = (u16*)(p.ws + OFF_AK); u16* AVT = (u16*)(p.ws + OFF_AVT);
  u16* DX = (u16*)(p.ws + OFF_DX); u16* HALO = (u16*)(p.ws + OFF_HALO);
  float* BETA = (float*)(p.ws + OFF_BETA); float* GG = (float*)(p.ws + OFF_G);
  const int xcd = blockIdx.x & 7, lw = blockIdx.x >> 3, LW = (gridDim.x - xcd + 7) >> 3;
  for (int i = lw;; i += LW) {
    int mt, nt; if (!tile_map(i, xcd, 129, 49, mt, nt)) break;
    const int m0 = mt * 128;
    const int n0 = nt < 24 ? nt * 128 : (nt < 48 ? 4096 + (nt - 24) * 128 : 8192);
    f32x16 acc[2][2]; zero_acc(acc);
    gemm_kloop(acc, [&](int m) { int mm = m < NTOK ? m : NTOK - 1; return hn + (size_t)mm * DM; }, [](int k0) { return (size_t)k0; }, wtin, m0, n0, smem);
    if (nt < 8) {
      epilogue_rows(acc, m0, n0, smem, [&](int m, int n, float4 a, float4 b) {
        if (m < NTOK) {
          a.x *= QSCALE; a.y *= QSCALE; a.z *= QSCALE; a.w *= QSCALE; b.x *= QSCALE; b.y *= QSCALE; b.z *= QSCALE; b.w *= QSCALE;
          *(uint4*)(AQ + (size_t)m * 1024 + n) = pack8(a, b);
        }
      });
    } else if (nt < 16) {
      epilogue_rows(acc, m0, n0, smem, [&](int m, int n, float4 a, float4 b) {
        if (m < NTOK) { int bb = m / LTOK, pos = m - bb * LTOK; *(uint4*)(AK + ((size_t)bb * LPAD + pos) * 1024 + (n - 1024)) = pack8(a, b); }
      });
    } else if (nt < 24) {
      epilogue_cols(acc, m0, n0, smem, [&](int m, int n, float4 a, float4 b) {
        if (m < NTOK) { int bb = m / LTOK, pos = m - bb * LTOK; *(uint4*)(AVT + ((size_t)(bb * 1024 + (n - 2048))) * LPAD + pos) = pack8(a, b); }
      });
    } else if (nt < 48) {
      epilogue_rows(acc, m0, n0, smem, [&](int m, int n, float4 a, float4 b) {
        if (m < NTOK) {
          int nn = n - 4096; int which = nn >> 10; int h = (nn >> 7) & 7; int d = nn & 127;
          int bb = m / LTOK, pos = m - bb * LTOK; int pp = pos + 48; int c = pp >> 6, rr = pp & 63;
          size_t blk = ((size_t)((bb * 8 + h) * NCH + c)) * 3 + which;
          uint4 o = pack8(a, b);
          *(uint4*)(DX + blk * 8192 + rr * 128 + d) = o;
          if (rr >= 61) *(uint4*)(HALO + blk * 384 + (rr - 61) * 128 + d) = o;
        }
      });
    } else {
      epilogue_rows(acc, m0, n0, smem, [&](int m, int n, float4 a, float4 b) {
        if (m < NTOK && n < 8208) {
          int isg = n >= 8200;
          int bb = m / LTOK, pos = m - bb * LTOK;
          float v[8] = {a.x, a.y, a.z, a.w, b.x, b.y, b.z, b.w};
#pragma unroll
          for (int h = 0; h < 8; ++h) {
            size_t o = (size_t)(bb * 8 + h) * LPAD + pos + 48;
            if (!isg) BETA[o] = sigmoidf_(v[h]);
            else { float z = v[h] + p.dt_bias[h]; float sp = z > 20.f ? z : log1pf(__expf(z)); GG[o] = -__expf(p.a_log[h]) * sp; }
          }
        }
      });
    }
  }
}

__device__ __forceinline__ void phase2(const Params& p, unsigned char* smem, const int lo, const int hi, const int worker, const int nworkers) {
  u16* DX = (u16*)(p.ws + OFF_DX); const u16* HALO = (const u16*)(p.ws + OFF_HALO);
  const float* BETA = (const float*)(p.ws + OFF_BETA); const float* GG = (const float*)(p.ws + OFF_G);
  u16* TA = (u16*)(p.ws + OFF_EXTRA);
  float* sin = (float*)smem;
  u16* sq = (u16*)(smem + 34304);
  u16* sk = sq + 64 * 136;
  u16* svT = sq;
  float* sgc = (float*)(smem + 34304 + 34816);
  float* sbeta = sgc + 64;
  float* sM = (float*)smem;
  const int tid = ltid(), lane = tid & 63, wave = tid >> 6;
  const int l31 = lane & 31, hf = lane >> 5;
  for (int idx2 = lo + worker; idx2 < hi; idx2 += nworkers) {
    const int bh = idx2 & 15, c = idx2 >> 4; const int it = bh * NCH + c; const int h = bh & 7;
    if (wave == 0) {
      const bool pad = (c == 0 && lane < 48);
      float g = pad ? 0.f : GG[(size_t)bh * LPAD + c * 64 + lane];
      float be = pad ? 0.f : BETA[(size_t)bh * LPAD + c * 64 + lane];
#pragma unroll
      for (int o = 1; o < 64; o <<= 1) { float t = __shfl_up(g, o); if (lane >= o) g += t; }
      sgc[lane] = g; sbeta[lane] = be;
    }
    for (int wi = 0; wi < 3; ++wi) {
      const int which = wi == 0 ? 2 : wi - 1;
      u16* X = DX + ((size_t)it * 3 + which) * 8192;
      const u16* H = HALO + ((size_t)(it - 1) * 3 + which) * 384;
      {
        u32x4 ld[5];
#pragma unroll
        for (int i = 0; i < 5; ++i) {
          const int idx = tid + 256 * i; const int rr = idx >> 4, c8 = (idx & 15) * 8; const int r = rr - 3;
          const bool zero = (idx >= 67 * 16) || (c == 0 && r < 48);
          const u16* srcp = (r < 0) ? (H + rr * 128 + c8) : (X + r * 128 + c8);
          u32x4 z = {0u, 0u, 0u, 0u};
          ld[i] = zero ? z : *(const u32x4*)srcp;
        }
#pragma unroll
        for (int i = 0; i < 5; ++i) {
          const int idx = tid + 256 * i; const int rr = idx >> 4, c8 = (idx & 15) * 8;
          if (idx < 67 * 16) {
            float4 a = make_float4(bflo(ld[i].x), bfhi(ld[i].x), bflo(ld[i].y), bfhi(ld[i].y));
            float4 b = make_float4(bflo(ld[i].z), bfhi(ld[i].z), bflo(ld[i].w), bfhi(ld[i].w));
            *(float4*)(sin + rr * 128 + c8) = a; *(float4*)(sin + rr * 128 + c8 + 4) = b;
          }
        }
      }
      __syncthreads();
      const int d0 = 2 * lane; const int ch = which * 1024 + h * 128 + d0;
      float w0[4], w1[4];
#pragma unroll
      for (int j = 0; j < 4; ++j) { w0[j] = p.conv_w[j * 3072 + ch]; w1[j] = p.conv_w[j * 3072 + ch + 1]; }
      for (int rb = 0; rb < 4; ++rb) {
        float y0[4], y1[4];
#pragma unroll
        for (int u = 0; u < 4; ++u) {
          const int r = wave * 16 + rb * 4 + u;
          float a0 = 0.f, a1 = 0.f;
#pragma unroll
          for (int j = 0; j < 4; ++j) { float2 xv = *(const float2*)(sin + (r + j) * 128 + d0); a0 += w0[j] * xv.x; a1 += w1[j] * xv.y; }
          y0[u] = siluf_(a0); y1[u] = siluf_(a1);
        }
        if (which < 2) {
          float ss[4];
#pragma unroll
          for (int u = 0; u < 4; ++u) ss[u] = y0[u] * y0[u] + y1[u] * y1[u];
#pragma unroll
          for (int o = 32; o > 0; o >>= 1) {
#pragma unroll
            for (int u = 0; u < 4; ++u) ss[u] += __shfl_xor(ss[u], o);
          }
#pragma unroll
          for (int u = 0; u < 4; ++u) {
            const int r = wave * 16 + rb * 4 + u;
            const bool pad = (c == 0 && r < 48);
            float sc = rsqrtf(ss[u] + 1e-6f) * (which == 0 ? 0.08838834764831845f : 1.f);
            if (pad) sc = 0.f;
            unsigned pk = cvtpk(y0[u] * sc, y1[u] * sc);
            *(unsigned*)(X + r * 128 + d0) = pk;
            *(unsigned*)((which == 0 ? sq : sk) + r * 136 + d0) = pk;
          }
        } else {
#pragma unroll
          for (int u = 0; u < 4; ++u) {
            const int r = wave * 16 + rb * 4 + u;
            const bool pad = (c == 0 && r < 48);
            float be = pad ? 0.f : sbeta[r];
            svT[d0 * 72 + r] = f2bf(y0[u] * be); svT[(d0 + 1) * 72 + r] = f2bf(y1[u] * be);
          }
        }
      }
      __syncthreads();
      if (which == 2) {
#pragma unroll
        for (int i = 0; i < 4; ++i) { int idx = tid + 256 * i; int e = idx >> 3, c8 = (idx & 7) * 8; *(uint4*)(X + e * 64 + c8) = *(const uint4*)(svT + e * 72 + c8); }
      }
    }
    const int ti = wave >> 1, tj = wave & 1;
    f32x16 kk, qk;
#pragma unroll
    for (int r = 0; r < 16; ++r) { kk[r] = 0.f; qk[r] = 0.f; }
#pragma unroll
    for (int s = 0; s < 8; ++s) {
      bf16x8 bj = *(const bf16x8*)(sk + (32 * tj + l31) * 136 + s * 16 + hf * 8);
      bf16x8 ak = *(const bf16x8*)(sk + (32 * ti + l31) * 136 + s * 16 + hf * 8);
      bf16x8 aq = *(const bf16x8*)(sq + (32 * ti + l31) * 136 + s * 16 + hf * 8);
      kk = mfma32(ak, bj, kk); qk = mfma32(aq, bj, qk);
    }
    __syncthreads();
    u16* Tg = TA + (size_t)it * 8704; u16* Ag = Tg + 4096; float* SCg = (float*)(Tg + 8192);
    {
      const int j = 32 * tj + l31; const float gcj = sgc[j];
#pragma unroll
      for (int r = 0; r < 16; ++r) {
        const int i = 32 * ti + 8 * (r >> 2) + 4 * hf + (r & 3);
        const float gci = sgc[i]; const float bi = sbeta[i];
        const float dec = __expf(gci - gcj);
        sM[i * 68 + j] = (j < i) ? bi * kk[r] * dec : 0.f;
        Ag[i * 64 + j] = f2bf((j <= i) ? qk[r] * dec : 0.f);
      }
    }
    __syncthreads();
    float* sTc = (float*)sq;
    if (wave == 0) {
      float* mycol = sTc + lane * 68;
#pragma unroll 1
      for (int blk = 0; blk < 4; ++blk) {
        const int r0 = blk * 16;
        float acc[16];
#pragma unroll
        for (int r = 0; r < 16; ++r) acc[r] = 0.f;
#pragma unroll 1
        for (int j = 0; j < r0; j += 4) {
          const float4 t4 = *(const float4*)(mycol + j);
#pragma unroll
          for (int r = 0; r < 16; ++r) {
            const float4 m4 = *(const float4*)(sM + (r0 + r) * 68 + j);
            acc[r] += (m4.x * t4.x + m4.y * t4.y) + (m4.z * t4.z + m4.w * t4.w);
          }
        }
        float tt[16];
#pragma unroll
        for (int r = 0; r < 16; ++r) {
          float s = acc[r];
#pragma unroll
          for (int q4 = 0; q4 < r; q4 += 4) {
            const float4 m4 = *(const float4*)(sM + (r0 + r) * 68 + r0 + q4);
            s += m4.x * tt[q4];
            if (q4 + 1 < r) s += m4.y * tt[q4 + 1];
            if (q4 + 2 < r) s += m4.z * tt[q4 + 2];
            if (q4 + 3 < r) s += m4.w * tt[q4 + 3];
          }
          tt[r] = ((r0 + r == lane) ? 1.f : 0.f) - s;
        }
#pragma unroll
        for (int r = 0; r < 16; r += 4) *(float4*)(mycol + r0 + r) = make_float4(tt[r], tt[r + 1], tt[r + 2], tt[r + 3]);
      }
    }
    __syncthreads();
#pragma unroll
    for (int i = 0; i < 2; ++i) {
      int idx = tid + 256 * i; int r = idx >> 3, c8 = (idx & 7) * 8; const float* s = sTc + c8 * 68 + r;
      uint4 o; o.x = cvtpk(s[0], s[68]); o.y = cvtpk(s[136], s[204]); o.z = cvtpk(s[272], s[340]); o.w = cvtpk(s[408], s[476]);
      *(uint4*)(Tg + r * 64 + c8) = o;
    }
    if (tid < 64) {
      float gc = sgc[tid], be = sbeta[tid]; float eg = __expf(gc);
      SCg[tid] = be; SCg[64 + tid] = be * eg; SCg[128 + tid] = eg; SCg[192 + tid] = __expf(sgc[63] - gc);
    }
    __syncthreads();
  }
}

__device__ __forceinline__ bf16x8 mk8(uint2 lo, uint2 hi) { u32x4 t = {lo.x, lo.y, hi.x, hi.y}; return __builtin_bit_cast(bf16x8, t); }

__device__ __forceinline__ void scan_chunked(const Params& p, unsigned char* smem, int bh, f32x16 (&S)[4], const int c_begin, const int c_end) {
  u16* DX = (u16*)(p.ws + OFF_DX); const u16* TA = (const u16*)(p.ws + OFF_EXTRA);
  const int tid = ltid(), lane = tid & 63, wave = tid >> 6;
  const int l31 = lane & 31, hf = lane >> 5;
  u16* sk = (u16*)smem;
  u16* sq = sk + 64 * 136;
  u16* sT = sq + 64 * 136;
  u16* sA = sT + 64 * 72;
  float* sSC = (float*)(sA + 64 * 72);
  u32x4 pk[4], pq[4], pT[2], pA[2]; uint2 pv[8]; float psc;
#pragma unroll 1
  for (int c = c_begin; c < c_end; ++c) {
    {
      const u16* Xq = DX + ((size_t)(bh * NCH + c) * 3) * 8192; const u16* Xk = Xq + 8192; const u16* Xv = Xk + 8192;
      const u16* Tg = TA + (size_t)(bh * NCH + c) * 8704; const u16* Ag = Tg + 4096;
#pragma unroll
      for (int i = 0; i < 4; ++i) { pk[i] = *(const u32x4*)(Xk + (tid + 256 * i) * 8); pq[i] = *(const u32x4*)(Xq + (tid + 256 * i) * 8); }
#pragma unroll
      for (int i = 0; i < 2; ++i) { pT[i] = *(const u32x4*)(Tg + (tid + 256 * i) * 8); pA[i] = *(const u32x4*)(Ag + (tid + 256 * i) * 8); }
      psc = ((const float*)(Tg + 8192))[tid];
#pragma unroll
      for (int i = 0; i < 8; ++i) pv[i] = *(const uint2*)(Xv + (wave * 32 + l31) * 64 + 32 * (i >> 2) + 8 * (i & 3) + 4 * hf);
    }
#pragma unroll
    for (int i = 0; i < 4; ++i) {
      int idx = tid + 256 * i; int row = idx >> 4, ch = idx & 15; const int po = (ch >> 1) * 16 + (ch & 1) * 4;
      u16* dk = sk + row * 136 + po; *(uint2*)dk = make_uint2(pk[i].x, pk[i].y); *(uint2*)(dk + 8) = make_uint2(pk[i].z, pk[i].w);
      u16* dq = sq + row * 136 + po; *(uint2*)dq = make_uint2(pq[i].x, pq[i].y); *(uint2*)(dq + 8) = make_uint2(pq[i].z, pq[i].w);
    }
#pragma unroll
    for (int i = 0; i < 2; ++i) {
      int idx = tid + 256 * i; int row = idx >> 3, ch = idx & 7; const int po = (ch >> 1) * 16 + (ch & 1) * 4;
      u16* dt = sT + row * 72 + po; *(uint2*)dt = make_uint2(pT[i].x, pT[i].y); *(uint2*)(dt + 8) = make_uint2(pT[i].z, pT[i].w);
      u16* da = sA + row * 72 + po; *(uint2*)da = make_uint2(pA[i].x, pA[i].y); *(uint2*)(da + 8) = make_uint2(pA[i].z, pA[i].w);
    }
    sSC[tid] = psc;
    lds_barrier();
    __builtin_amdgcn_sched_barrier(0);
    u32x4 yf[4];
    {
      f32x16 x0, x1;
#pragma unroll
      for (int r = 0; r < 16; ++r) { x0[r] = 0.f; x1[r] = 0.f; }
#pragma unroll
      for (int dt = 0; dt < 4; ++dt)
#pragma unroll
        for (int s = 0; s < 2; ++s) {
          u32x4 sb = {cvtpk(S[dt][8 * s + 0], S[dt][8 * s + 1]), cvtpk(S[dt][8 * s + 2], S[dt][8 * s + 3]), cvtpk(S[dt][8 * s + 4], S[dt][8 * s + 5]), cvtpk(S[dt][8 * s + 6], S[dt][8 * s + 7])};
          const bf16x8 k0f = *(const bf16x8*)(sk + (l31) * 136 + 32 * dt + 16 * s + 8 * hf);
          const bf16x8 k1f = *(const bf16x8*)(sk + (32 + l31) * 136 + 32 * dt + 16 * s + 8 * hf);
          x0 = mfma32(k0f, __builtin_bit_cast(bf16x8, sb), x0);
          x1 = mfma32(k1f, __builtin_bit_cast(bf16x8, sb), x1);
        }
#pragma unroll
      for (int g = 0; g < 4; ++g) {
        {
          float4 bg4 = *(const float4*)(sSC + 64 + 8 * g + 4 * hf);
          uint2 vb = pv[g];
          yf[(g >> 1)][(g & 1) * 2 + 0] = cvtpk(bflo(vb.x) - bg4.x * x0[4 * g + 0], bfhi(vb.x) - bg4.y * x0[4 * g + 1]);
          yf[(g >> 1)][(g & 1) * 2 + 1] = cvtpk(bflo(vb.y) - bg4.z * x0[4 * g + 2], bfhi(vb.y) - bg4.w * x0[4 * g + 3]);
        }
        {
          float4 bg4 = *(const float4*)(sSC + 64 + 32 + 8 * g + 4 * hf);
          uint2 vb = pv[4 + g];
          yf[2 + (g >> 1)][(g & 1) * 2 + 0] = cvtpk(bflo(vb.x) - bg4.x * x1[4 * g + 0], bfhi(vb.x) - bg4.y * x1[4 * g + 1]);
          yf[2 + (g >> 1)][(g & 1) * 2 + 1] = cvtpk(bflo(vb.y) - bg4.z * x1[4 * g + 2], bfhi(vb.y) - bg4.w * x1[4 * g + 3]);
        }
      }
    }
    __builtin_amdgcn_sched_barrier(0);
    u32x4 vnf[4];
    {
      f32x16 v0, v1;
#pragma unroll
      for (int r = 0; r < 16; ++r) { v0[r] = 0.f; v1[r] = 0.f; }
#pragma unroll
      for (int s = 0; s < 4; ++s) {
        const bf16x8 t0f = *(const bf16x8*)(sT + (l31) * 72 + 16 * s + 8 * hf);
        const bf16x8 t1f = *(const bf16x8*)(sT + (32 + l31) * 72 + 16 * s + 8 * hf);
        v0 = mfma32(t0f, __builtin_bit_cast(bf16x8, yf[s]), v0);
        v1 = mfma32(t1f, __builtin_bit_cast(bf16x8, yf[s]), v1);
      }
#pragma unroll
      for (int g = 0; g < 4; ++g) {
        vnf[(g >> 1)][(g & 1) * 2 + 0] = cvtpk(v0[4 * g + 0], v0[4 * g + 1]);
        vnf[(g >> 1)][(g & 1) * 2 + 1] = cvtpk(v0[4 * g + 2], v0[4 * g + 3]);
        vnf[2 + (g >> 1)][(g & 1) * 2 + 0] = cvtpk(v1[4 * g + 0], v1[4 * g + 1]);
        vnf[2 + (g >> 1)][(g & 1) * 2 + 1] = cvtpk(v1[4 * g + 2], v1[4 * g + 3]);
      }
    }
    __builtin_amdgcn_sched_barrier(0);
    u16* Oq = DX + ((size_t)(bh * NCH + c) * 3) * 8192;
    {
      f32x16 o0, o1;
#pragma unroll
      for (int r = 0; r < 16; ++r) { o0[r] = 0.f; o1[r] = 0.f; }
#pragma unroll
      for (int dt = 0; dt < 4; ++dt)
#pragma unroll
        for (int s = 0; s < 2; ++s) {
          u32x4 sb = {cvtpk(S[dt][8 * s + 0], S[dt][8 * s + 1]), cvtpk(S[dt][8 * s + 2], S[dt][8 * s + 3]), cvtpk(S[dt][8 * s + 4], S[dt][8 * s + 5]), cvtpk(S[dt][8 * s + 6], S[dt][8 * s + 7])};
          const bf16x8 q0f = *(const bf16x8*)(sq + (l31) * 136 + 32 * dt + 16 * s + 8 * hf);
          const bf16x8 q1f = *(const bf16x8*)(sq + (32 + l31) * 136 + 32 * dt + 16 * s + 8 * hf);
          o0 = mfma32(q0f, __builtin_bit_cast(bf16x8, sb), o0);
          o1 = mfma32(q1f, __builtin_bit_cast(bf16x8, sb), o1);
        }
#pragma unroll
      for (int g = 0; g < 4; ++g) {
        float4 e0 = *(const float4*)(sSC + 128 + 8 * g + 4 * hf), e1 = *(const float4*)(sSC + 128 + 32 + 8 * g + 4 * hf);
        o0[4 * g + 0] *= e0.x; o0[4 * g + 1] *= e0.y; o0[4 * g + 2] *= e0.z; o0[4 * g + 3] *= e0.w;
        o1[4 * g + 0] *= e1.x; o1[4 * g + 1] *= e1.y; o1[4 * g + 2] *= e1.z; o1[4 * g + 3] *= e1.w;
      }
#pragma unroll
      for (int s = 0; s < 4; ++s) {
        const bf16x8 a0f = *(const bf16x8*)(sA + (l31) * 72 + 16 * s + 8 * hf);
        const bf16x8 a1f = *(const bf16x8*)(sA + (32 + l31) * 72 + 16 * s + 8 * hf);
        o0 = mfma32(a0f, __builtin_bit_cast(bf16x8, vnf[s]), o0);
        o1 = mfma32(a1f, __builtin_bit_cast(bf16x8, vnf[s]), o1);
      }
#pragma unroll
      for (int r = 0; r < 16; ++r) {
        Oq[(8 * (r >> 2) + 4 * hf + (r & 3)) * 128 + wave * 32 + l31] = f2bf(o0[r]);
        Oq[(32 + 8 * (r >> 2) + 4 * hf + (r & 3)) * 128 + wave * 32 + l31] = f2bf(o1[r]);
      }
    }
    __builtin_amdgcn_sched_barrier(0);
    const float cd = sSC[128 + 63];
#pragma unroll
    for (int dt = 0; dt < 4; ++dt)
#pragma unroll
      for (int r = 0; r < 16; ++r) S[dt][r] *= cd;
    u32x4 vs[4];
#pragma unroll
    for (int s = 0; s < 4; ++s) {
      const float4 e0 = *(const float4*)(sSC + 192 + 16 * s + 4 * hf), e1 = *(const float4*)(sSC + 192 + 16 * s + 8 + 4 * hf);
      vs[s].x = cvtpk(bflo(vnf[s].x) * e0.x, bfhi(vnf[s].x) * e0.y); vs[s].y = cvtpk(bflo(vnf[s].y) * e0.z, bfhi(vnf[s].y) * e0.w);
      vs[s].z = cvtpk(bflo(vnf[s].z) * e1.x, bfhi(vnf[s].z) * e1.y); vs[s].w = cvtpk(bflo(vnf[s].w) * e1.z, bfhi(vnf[s].w) * e1.w);
    }
    {
      u32x4 id1 = {0u, 0u, 0u, 0u}, id2 = {0u, 0u, 0u, 0u};
      {
        const int l15 = l31 & 15;
        const int jsel = (((l15 >> 2) & 1) == hf) ? (4 * (l15 >> 3) + (l15 & 3)) : -1;
        const int j1 = (l31 < 16) ? jsel : -1;
        const int j2 = (l31 >= 16) ? jsel : -1;
        const unsigned one_lo = 0x3f80u, one_hi = 0x3f800000u;
#pragma unroll
        for (int w = 0; w < 4; ++w) {
          id1[w] = (j1 == 2 * w) ? one_lo : ((j1 == 2 * w + 1) ? one_hi : 0u);
          id2[w] = (j2 == 2 * w) ? one_lo : ((j2 == 2 * w + 1) ? one_hi : 0u);
        }
      }
      const bf16x8 B1 = __builtin_bit_cast(bf16x8, id1), B2 = __builtin_bit_cast(bf16x8, id2);
#pragma unroll
      for (int dt = 0; dt < 4; ++dt)
#pragma unroll
        for (int mt = 0; mt < 2; ++mt) {
          f32x16 kt;
#pragma unroll
          for (int r = 0; r < 16; ++r) kt[r] = 0.f;
          const u16* k0 = sk + (32 * mt + l31) * 136 + 32 * dt + 8 * hf;
          kt = mfma32(*(const bf16x8*)(k0), B1, kt);
          kt = mfma32(*(const bf16x8*)(k0 + 16), B2, kt);
#pragma unroll
          for (int s2 = 0; s2 < 2; ++s2) {
            u32x4 af = {cvtpk(kt[8 * s2 + 0], kt[8 * s2 + 1]), cvtpk(kt[8 * s2 + 2], kt[8 * s2 + 3]), cvtpk(kt[8 * s2 + 4], kt[8 * s2 + 5]), cvtpk(kt[8 * s2 + 6], kt[8 * s2 + 7])};
            S[dt] = mfma32(__builtin_bit_cast(bf16x8, af), __builtin_bit_cast(bf16x8, vs[2 * mt + s2]), S[dt]);
          }
        }
    }
    lds_barrier();
  }
}

__device__ __forceinline__ void attn_item(const Params& p, unsigned char* smem, int b, int h, int qb, float lam) {
  int tid_ = ltid();
  const int tid = tid_, lane = tid & 63, wave = tid >> 6;
  const int l31 = lane & 31, hf = lane >> 5;
  const int map = wave >> 1, r0 = (wave & 1) * 32;
  u16* AQ = (u16*)(p.ws + OFF_AQ); const u16* AK = (const u16*)(p.ws + OFF_AK); const u16* AVT = (const u16*)(p.ws + OFF_AVT);
  u16* sK = (u16*)smem;
  float* sO = (float*)smem;
  const int t0 = qb * 64; const int ntiles = qb + 2;
  const size_t qrow = (size_t)(b * LTOK + NMETA + t0 + r0 + l31);
  bf16x8 qf[4];
#pragma unroll
  for (int s = 0; s < 4; ++s) qf[s] = *(const bf16x8*)(AQ + qrow * 1024 + h * 128 + map * 64 + s * 16 + hf * 8);
  f32x16 oacc[4];
#pragma unroll
  for (int d = 0; d < 4; ++d)
#pragma unroll
    for (int r = 0; r < 16; ++r) oacc[d][r] = 0.f;
  float m_run = -1e30f, l_run = 0.f;
  const int qpos = NMETA + t0 + r0 + l31;
  const u16* kbase = AK + ((size_t)b * LPAD) * 1024 + h * 128;
  const u16* vbase = AVT + ((size_t)(b * 8 + h) * 128) * LPAD;
  const int kc = tid & 15, kr = tid >> 4;
  const int vc = tid & 7, vr = tid >> 3;
  u32x4 ak[4], av[4], bk[4], bv[4];
  auto gload = [&](u32x4 (&rk)[4], u32x4 (&rv)[4], int kt) {
#pragma unroll
    for (int i = 0; i < 4; ++i) {
      rk[i] = *(const u32x4*)(kbase + (size_t)(kt * 64 + kr + 16 * i) * 1024 + kc * 8);
      rv[i] = *(const u32x4*)(vbase + (size_t)(vr + 32 * i) * LPAD + kt * 64 + vc * 8);
    }
  };
  auto swrite = [&](const u32x4 (&rk)[4], const u32x4 (&rv)[4], int buf) {
    u16* bK = sK + buf * 17920; u16* bV = bK + 64 * 136;
#pragma unroll
    for (int i = 0; i < 4; ++i) {
      *(u32x4*)(bK + (kr + 16 * i) * 136 + kc * 8) = rk[i];
      u16* dst = bV + (vr + 32 * i) * 72 + (vc >> 1) * 16 + (vc & 1) * 4;
      *(uint2*)dst = make_uint2(rv[i].x, rv[i].y); *(uint2*)(dst + 8) = make_uint2(rv[i].z, rv[i].w);
    }
  };
  auto compute = [&](int kt, int buf) {
    const u16* bK = sK + buf * 17920; const u16* bV = bK + 64 * 136;
    f32x16 st[2];
#pragma unroll
    for (int mt = 0; mt < 2; ++mt) {
#pragma unroll
      for (int r = 0; r < 16; ++r) st[mt][r] = 0.f;
#pragma unroll
      for (int s = 0; s < 4; ++s) {
        bf16x8 kf = *(const bf16x8*)(bK + (mt * 32 + l31) * 136 + map * 64 + s * 16 + hf * 8);
        st[mt] = mfma32(kf, qf[s], st[mt]);
      }
    }
    if (kt >= ntiles - 2) {
#pragma unroll
      for (int mt = 0; mt < 2; ++mt)
#pragma unroll
        for (int r = 0; r < 16; ++r) {
          int key = kt * 64 + mt * 32 + 8 * (r >> 2) + 4 * hf + (r & 3);
          if (key > qpos) st[mt][r] = -1e30f;
        }
    }
    float mx = -1e30f;
#pragma unroll
    for (int mt = 0; mt < 2; ++mt)
#pragma unroll
      for (int r = 0; r < 16; ++r) mx = fmaxf(mx, st[mt][r]);
    mx = fmaxf(mx, __shfl_xor(mx, 32));
    const float m_new = fmaxf(m_run, mx);
    const float alpha = __builtin_amdgcn_exp2f(m_run - m_new);
    float rsum = 0.f;
#pragma unroll
    for (int mt = 0; mt < 2; ++mt)
#pragma unroll
      for (int r = 0; r < 16; ++r) { float pv = __builtin_amdgcn_exp2f(st[mt][r] - m_new); st[mt][r] = pv; rsum += pv; }
    l_run = l_run * alpha + rsum; m_run = m_new;
#pragma unroll
    for (int d = 0; d < 4; ++d)
#pragma unroll
      for (int r = 0; r < 16; ++r) oacc[d][r] *= alpha;
#pragma unroll
    for (int s = 0; s < 4; ++s) {
      const int mt = s >> 1, ss = s & 1;
      u32x4 pt = {cvtpk(st[mt][8 * ss + 0], st[mt][8 * ss + 1]), cvtpk(st[mt][8 * ss + 2], st[mt][8 * ss + 3]),
                  cvtpk(st[mt][8 * ss + 4], st[mt][8 * ss + 5]), cvtpk(st[mt][8 * ss + 6], st[mt][8 * ss + 7])};
      bf16x8 pf = __builtin_bit_cast(bf16x8, pt);
#pragma unroll
      for (int d = 0; d < 4; ++d) {
        const bf16x8 vf = *(const bf16x8*)(bV + (d * 32 + l31) * 72 + mt * 32 + ss * 16 + hf * 8);
        oacc[d] = mfma32(vf, pf, oacc[d]);
      }
    }
  };
  gload(ak, av, 0); swrite(ak, av, 0); gload(bk, bv, 1);
  lds_barrier();
#pragma unroll 1
  for (int kt = 0; kt < ntiles; kt += 2) {
    if (kt + 2 < ntiles) gload(ak, av, kt + 2);
    compute(kt, 0);
    if (kt + 1 < ntiles) swrite(bk, bv, 1);
    lds_barrier();
    if (kt + 1 < ntiles) {
      if (kt + 3 < ntiles) gload(bk, bv, kt + 3);
      compute(kt + 1, 1);
      if (kt + 2 < ntiles) swrite(ak, av, 0);
      lds_barrier();
    }
  }
  const float l_tot = l_run + __shfl_xor(l_run, 32);
  const float inv = 1.f / l_tot;
#pragma unroll
  for (int d = 0; d < 4; ++d)
#pragma unroll
    for (int g = 0; g < 4; ++g) {
      float4 o4 = make_float4(oacc[d][4 * g] * inv, oacc[d][4 * g + 1] * inv, oacc[d][4 * g + 2] * inv, oacc[d][4 * g + 3] * inv);
      *(float4*)(sO + ((map * 64 + r0 + l31) * 132 + d * 32 + 8 * g + 4 * hf)) = o4;
    }
  __syncthreads();
  {
    const int q = tid >> 2, qq = tid & 3;
    const float4* o0 = (const float4*)(sO + (q * 132 + qq * 32)); const float4* o1 = (const float4*)(sO + ((64 + q) * 132 + qq * 32));
    float ss = 0.f;
#pragma unroll
    for (int i = 0; i < 8; ++i) {
      float4 a = o0[i], c = o1[i];
      float dx = a.x - lam * c.x, dy = a.y - lam * c.y, dz = a.z - lam * c.z, dw = a.w - lam * c.w;
      ss += dx * dx + dy * dy + dz * dz + dw * dw;
    }
    ss += __shfl_xor(ss, 1); ss += __shfl_xor(ss, 2);
    const float rsn = rsqrtf(ss * (1.f / 128.f) + 1e-6f) * 0.8f;
    const float4* nw = (const float4*)(p.attn_norm_w + qq * 32);
    uint4* dst = (uint4*)(AQ + (size_t)(b * LTOK + NMETA + t0 + q) * 1024 + h * 128 + qq * 32);
#pragma unroll
    for (int i = 0; i < 4; ++i) {
      float4 a0 = o0[2 * i], c0 = o1[2 * i], a1 = o0[2 * i + 1], c1 = o1[2 * i + 1];
      float4 w0 = nw[2 * i], w1 = nw[2 * i + 1];
      uint4 o;
      o.x = cvtpk((a0.x - lam * c0.x) * rsn * w0.x, (a0.y - lam * c0.y) * rsn * w0.y);
      o.y = cvtpk((a0.z - lam * c0.z) * rsn * w0.z, (a0.w - lam * c0.w) * rsn * w0.w);
      o.z = cvtpk((a1.x - lam * c1.x) * rsn * w1.x, (a1.y - lam * c1.y) * rsn * w1.y);
      o.w = cvtpk((a1.z - lam * c1.z) * rsn * w1.z, (a1.w - lam * c1.w) * rsn * w1.w);
      dst[i] = o;
    }
  }
  __syncthreads();
}

__device__ __forceinline__ void phase3(const Params& p, unsigned char* smem) {
  __shared__ int s_item;
  const int tid = ltid();
  const bool is_scan = (blockIdx.x < 16);
  float* ssave = (float*)(p.ws + OFF_PSQ) + ((size_t)blockIdx.x * 256 + tid) * 64;
  if (is_scan) {
    f32x16 S[4];
#pragma unroll
    for (int d = 0; d < 4; ++d)
#pragma unroll
      for (int r = 0; r < 16; ++r) S[d][r] = 0.f;
    scan_chunked(p, smem, blockIdx.x, S, 0, P2_SPLIT);
#pragma unroll
    for (int d = 0; d < 4; ++d)
#pragma unroll
      for (int r = 0; r < 16; r += 4) *(float4*)(ssave + d * 16 + r) = make_float4(S[d][r], S[d][r + 1], S[d][r + 2], S[d][r + 3]);
  } else {
    phase2(p, smem, P2_SPLIT * 16, NCH * 16, blockIdx.x - 16, gridDim.x - 16);
  }
  cg::this_grid().sync();
  if (is_scan) {
    f32x16 S[4];
#pragma unroll
    for (int d = 0; d < 4; ++d)
#pragma unroll
      for (int r = 0; r < 16; r += 4) { float4 v = *(const float4*)(ssave + d * 16 + r); S[d][r] = v.x; S[d][r + 1] = v.y; S[d][r + 2] = v.z; S[d][r + 3] = v.w; }
    scan_chunked(p, smem, blockIdx.x, S, P2_SPLIT, NCH);
  }
  int* cnt = (int*)(p.ws + OFF_CTL);
  const float lam = ((const float*)(p.ws + OFF_CTL))[16];
  const int myq = blockIdx.x & 7;
  for (int qq = 0; qq < 8; ++qq) {
    const int q = (myq + qq) & 7;
    while (true) {
      if (tid == 0) s_item = atomicAdd(&cnt[q], 1);
      __syncthreads();
      const int idx = s_item;
      __syncthreads();
      if (idx >= 256) break;
      attn_item(p, smem, idx & 1, q, 127 - (idx >> 1), lam);
    }
  }
}

__device__ __forceinline__ int tokrow_of(int m) { int b = m >> 13; return b * LTOK + NMETA + (m & 8191); }

__device__ __forceinline__ void phase4(const Params& p, unsigned char* smem) {
  const u16* hn = (const u16*)p.out; const u16* wtin = hn + (size_t)NTOK * DM;
  u16* AQ = (u16*)(p.ws + OFF_AQ); u16* DX = (u16*)(p.ws + OFF_DX);
  u16* SGA = (u16*)(p.ws + OFF_AK); u16* SGD = (u16*)(p.ws + OFF_AVT);
  const int xcd = blockIdx.x & 7, lw = blockIdx.x >> 3, LW = (gridDim.x - xcd + 7) >> 3;
  for (int i = lw;; i += LW) {
    int mt, nt; if (!tile_map(i, xcd, 128, 32, mt, nt)) break;
    const int m0 = mt * 128;
    const int n0 = nt < 8 ? 3072 + nt * 128 : (nt < 16 ? 7168 + (nt - 8) * 128 : 8208 + (nt - 16) * 128);
    f32x16 acc[2][2]; zero_acc(acc);
    gemm_kloop(acc, [&](int m) { return hn + (size_t)tokrow_of(m) * DM; }, [](int k0) { return (size_t)k0; }, wtin, m0, n0, smem);
    if (nt < 8) {
      epilogue_rows(acc, m0, n0, smem, [&](int m, int n, float4 a, float4 b) {
        uint4* ptr = (uint4*)(AQ + (size_t)tokrow_of(m) * 1024 + (n - 3072));
        uint4 o = *ptr;
        a.x = bflo(o.x) * siluf_(a.x); a.y = bfhi(o.x) * siluf_(a.y); a.z = bflo(o.y) * siluf_(a.z); a.w = bfhi(o.y) * siluf_(a.w);
        b.x = bflo(o.z) * siluf_(b.x); b.y = bfhi(o.z) * siluf_(b.y); b.z = bflo(o.w) * siluf_(b.z); b.w = bfhi(o.w) * siluf_(b.w);
        *ptr = pack8(a, b);
      });
    } else if (nt < 16) {
      epilogue_rows(acc, m0, n0, smem, [&](int m, int n, float4 a, float4 b) {
        int col = n - 7168; int h = col >> 7, d = col & 127;
        int bb = m >> 13, t = m & 8191; int bh = bb * 8 + h; int pp = t + 64;
        uint4* ptr = (uint4*)(DX + (((size_t)(bh * NCH + (pp >> 6))) * 3) * 8192 + (pp & 63) * 128 + d);
        uint4 o = *ptr;
        float o0 = bflo(o.x), o1 = bfhi(o.x), o2 = bflo(o.y), o3 = bfhi(o.y), o4 = bflo(o.z), o5 = bfhi(o.z), o6 = bflo(o.w), o7 = bfhi(o.w);
        float sq = o0 * o0 + o1 * o1 + o2 * o2 + o3 * o3 + o4 * o4 + o5 * o5 + o6 * o6 + o7 * o7;
        sq += __shfl_xor(sq, 1); sq += __shfl_xor(sq, 2); sq += __shfl_xor(sq, 4); sq += __shfl_xor(sq, 8);
        float rs = rsqrtf(sq * (1.f / 128.f) + 1e-6f);
        float4 w0 = *(const float4*)(p.dn_norm_w + d), w1 = *(const float4*)(p.dn_norm_w + d + 4);
        a.x = o0 * rs * w0.x * siluf_(a.x); a.y = o1 * rs * w0.y * siluf_(a.y); a.z = o2 * rs * w0.z * siluf_(a.z); a.w = o3 * rs * w0.w * siluf_(a.w);
        b.x = o4 * rs * w1.x * siluf_(b.x); b.y = o5 * rs * w1.y * siluf_(b.y); b.z = o6 * rs * w1.z * siluf_(b.z); b.w = o7 * rs * w1.w * siluf_(b.w);
        *ptr = pack8(a, b);
      });
    } else {
      epilogue_rows(acc, m0, n0, smem, [&](int m, int n, float4 a, float4 b) {
        int col = n - 8208; u16* dst = col < 1024 ? SGA + col : SGD + (col - 1024);
        a.x = sigmoidf_(a.x); a.y = sigmoidf_(a.y); a.z = sigmoidf_(a.z); a.w = sigmoidf_(a.w);
        b.x = sigmoidf_(b.x); b.y = sigmoidf_(b.y); b.z = sigmoidf_(b.z); b.w = sigmoidf_(b.w);
        *(uint4*)(dst + (size_t)m * 1024) = pack8(a, b);
      });
    }
  }
}

__device__ __forceinline__ void phase5(const Params& p, unsigned char* smem) {
  const u16* AQ = (const u16*)(p.ws + OFF_AQ); const u16* DX = (const u16*)(p.ws + OFF_DX);
  const u16* SGA = (const u16*)(p.ws + OFF_AK); const u16* SGD = (const u16*)(p.ws + OFF_AVT);
  const u16* wat = (const u16*)(p.ws + OFF_W3); const u16* wdt = wat + 1024 * 1024;
  u16* MERGED = (u16*)(p.ws + OFF_EXTRA);
  const int xcd = blockIdx.x & 7, lw = blockIdx.x >> 3, LW = (gridDim.x - xcd + 7) >> 3;
  for (int i = lw;; i += LW) {
    int mt, nt; if (!tile_map(i, xcd, 128, 8, mt, nt)) break;
    const int m0 = mt * 128, n0 = nt * 128;
    f32x16 acc[2][2]; zero_acc(acc);
    gemm_kloop(acc, [&](int m) { return AQ + (size_t)tokrow_of(m) * 1024; }, [](int k0) { return (size_t)k0; }, wat, m0, n0, smem);
    epilogue_rows(acc, m0, n0, smem, [&](int m, int n, float4 a, float4 b) {
      uint4 g = *(const uint4*)(SGA + (size_t)m * 1024 + n);
      a.x *= bflo(g.x); a.y *= bfhi(g.x); a.z *= bflo(g.y); a.w *= bfhi(g.y); b.x *= bflo(g.z); b.y *= bfhi(g.z); b.z *= bflo(g.w); b.w *= bfhi(g.w);
      *(uint4*)(MERGED + (size_t)m * 1024 + n) = pack8(a, b);
    });
  }
  for (int i = lw;; i += LW) {
    int mt, nt; if (!tile_map(i, xcd, 128, 8, mt, nt)) break;
    const int m0 = mt * 128, n0 = nt * 128;
    f32x16 acc[2][2]; zero_acc(acc);
    gemm_kloop(acc, [&](int m) {
      int bb = m >> 13, t = m & 8191; int pp = t + 64;
      return DX + (((size_t)((bb * 8) * NCH + (pp >> 6))) * 3) * 8192 + (pp & 63) * 128;
    }, [](int k0) { return (size_t)(k0 >> 7) * ((size_t)NCH * 3 * 8192) + (size_t)(k0 & 127); }, wdt, m0, n0, smem);
    epilogue_rows(acc, m0, n0, smem, [&](int m, int n, float4 a, float4 b) {
      uint4 g = *(const uint4*)(SGD + (size_t)m * 1024 + n);
      uint4* ptr = (uint4*)(MERGED + (size_t)m * 1024 + n);
      uint4 o = *ptr;
      a.x = bflo(o.x) + a.x * bflo(g.x); a.y = bfhi(o.x) + a.y * bfhi(g.x); a.z = bflo(o.y) + a.z * bflo(g.y); a.w = bfhi(o.y) + a.w * bfhi(g.y);
      b.x = bflo(o.z) + b.x * bflo(g.z); b.y = bfhi(o.z) + b.y * bfhi(g.z); b.z = bflo(o.w) + b.z * bflo(g.w); b.w = bfhi(o.w) + b.w * bfhi(g.w);
      *ptr = pack8(a, b);
    });
  }
}

__device__ __forceinline__ void phase6(const Params& p, unsigned char* smem) {
  const u16* MERGED = (const u16*)(p.ws + OFF_EXTRA);
  const u16* wot = (const u16*)(p.ws + OFF_W3) + 2 * 1024 * 1024;
  float* PSUM = (float*)(p.ws + OFF_PSUM);
  const int xcd = blockIdx.x & 7, lw = blockIdx.x >> 3, LW = (gridDim.x - xcd + 7) >> 3;
  for (int i = lw;; i += LW) {
    int mt, nt; if (!tile_map(i, xcd, 128, 8, mt, nt)) break;
    const int m0 = mt * 128, n0 = nt * 128;
    f32x16 acc[2][2]; zero_acc(acc);
    gemm_kloop(acc, [&](int m) { return MERGED + (size_t)m * 1024; }, [](int k0) { return (size_t)k0; }, wot, m0, n0, smem);
    epilogue_rows(acc, m0, n0, smem, [&](int m, int n, float4 a, float4 b) {
      const float4* xp = (const float4*)(p.x + (size_t)m * 1024 + n);
      float4 x0 = xp[0], x1 = xp[1];
      a.x += x0.x; a.y += x0.y; a.z += x0.z; a.w += x0.w; b.x += x1.x; b.y += x1.y; b.z += x1.z; b.w += x1.w;
      float4* op = (float4*)(p.out + (size_t)m * 1024 + n);
      op[0] = a; op[1] = b;
      float sq = a.x * a.x + a.y * a.y + a.z * a.z + a.w * a.w + b.x * b.x + b.y * b.y + b.z * b.z + b.w * b.w;
      sq += __shfl_xor(sq, 1); sq += __shfl_xor(sq, 2); sq += __shfl_xor(sq, 4); sq += __shfl_xor(sq, 8);
      if ((ltid() & 15) == 0) PSUM[(size_t)nt * NX + m] = sq;
    });
  }
}

__device__ __forceinline__ void phase7(const Params& p) {
  const float* PSUM = (const float*)(p.ws + OFF_PSUM);
  const int tid__ = ltid(); const int lane = tid__ & 63, wave = tid__ >> 6;
  for (int it = blockIdx.x; it < NX / 4; it += gridDim.x) {
    int row = it * 4 + wave;
    float tot = 0.f;
#pragma unroll
    for (int j = 0; j < 8; ++j) tot += PSUM[(size_t)j * NX + row];
    float rs = rsqrtf(tot * (1.f / 1024.f) + 1e-6f);
    float4* o = (float4*)(p.out + (size_t)row * 1024);
#pragma unroll
    for (int i = 0; i < 4; ++i) {
      float4 v = o[lane + 64 * i]; float4 w = ((const float4*)p.final_w)[lane + 64 * i];
      v.x *= rs * w.x; v.y *= rs * w.y; v.z *= rs * w.z; v.w *= rs * w.w;
      o[lane + 64 * i] = v;
    }
  }
}

__global__ void __launch_bounds__(256, 2) mega(Params p) {
  extern __shared__ __attribute__((aligned(16))) unsigned char smem[];
  cg::grid_group grid = cg::this_grid();
  phase0(p, smem); grid.sync();
  phase1(p, smem); grid.sync();
  phase2(p, smem, 0, P2_SPLIT * 16, blockIdx.x, gridDim.x); grid.sync();
  phase3(p, smem); grid.sync();
  phase4(p, smem); grid.sync();
  phase5(p, smem); grid.sync();
  phase6(p, smem); grid.sync();
  phase7(p);
}

extern "C" void kernel_launch(void* const* d_in, const int* in_sizes, int n_in, void* d_out, int out_size, void* d_ws, size_t ws_size, hipStream_t stream) {
  static int grid_blocks = 0;
  if (!grid_blocks) {
    int dev = 0, cus = 0, per_cu = 0;
    hipGetDevice(&dev);
    hipDeviceGetAttribute(&cus, hipDeviceAttributeMultiprocessorCount, dev);
    hipFuncSetAttribute((const void*)mega, hipFuncAttributeMaxDynamicSharedMemorySize, SMEM_BYTES);
    hipOccupancyMaxActiveBlocksPerMultiprocessor(&per_cu, (const void*)mega, 256, SMEM_BYTES);
    if (per_cu < 1) per_cu = 1;
    if (per_cu > 2) per_cu = 2;
    grid_blocks = cus * per_cu;
    if (ws_size < WS_END) fprintf(stderr, "workspace too small: %zu < %zu\n", ws_size, (size_t)WS_END);
  }
  Params p{};
  p.x = (const float*)d_in[0]; p.meta = (const float*)d_in[1]; p.norm_w = (const float*)d_in[2]; p.w_in = (const float*)d_in[3];
  p.lq1 = (const float*)d_in[4]; p.lk1 = (const float*)d_in[5]; p.lq2 = (const float*)d_in[6]; p.lk2 = (const float*)d_in[7];
  p.attn_norm_w = (const float*)d_in[8]; p.conv_w = (const float*)d_in[9]; p.a_log = (const float*)d_in[10]; p.dt_bias = (const float*)d_in[11];
  p.dn_norm_w = (const float*)d_in[12]; p.w_a = (const float*)d_in[13]; p.w_d = (const float*)d_in[14]; p.w_o = (const float*)d_in[15]; p.final_w = (const float*)d_in[16];
  p.out = (float*)d_out; p.ws = (unsigned char*)d_ws;
  void* args[] = {&p};
  hipError_t e = hipLaunchCooperativeKernel((const void*)mega, dim3(grid_blocks), dim3(256), args, SMEM_BYTES, stream);
  if (e != hipSuccess) fprintf(stderr, "cooperative launch failed: %s (grid %d)\n", hipGetErrorString(e), grid_blocks);
}
```

```cpp
#include <hip/hip_runtime.h>
#include <hip/hip_cooperative_groups.h>
#include <stdint.h>
#include <stdio.h>
namespace cg = cooperative_groups;

typedef unsigned short u16;
typedef __attribute__((ext_vector_type(8))) short bf16x8;
typedef __attribute__((ext_vector_type(16))) float f32x16;
typedef __attribute__((ext_vector_type(4))) unsigned u32x4;

constexpr int SEQ = 8192, NMETA = 16, LTOK = 8208, DM = 1024, NTOK = 16416, NX = 16384;
constexpr int LPAD = 8256, NCH = 129, INDIM = 10256;
constexpr float QSCALE = 0.125f * 1.44269504088896f;

constexpr size_t OFF_AQ = 0;
constexpr size_t OFF_AK = 33619968;
constexpr size_t OFF_AVT = 67436544;
constexpr size_t OFF_DX = 101253120;
constexpr size_t OFF_HALO = 202702848;
constexpr size_t OFF_EXTRA = 207458304;
constexpr size_t OFF_W3 = 243388416;
constexpr size_t OFF_BETA = 249679872;
constexpr size_t OFF_G = 250208256;
constexpr size_t OFF_PSQ = 250736640;
constexpr size_t OFF_PSUM = 252850176;
constexpr size_t OFF_CTL = 253898752;
constexpr size_t WS_END = 253902848;
constexpr size_t OFF_BAR = OFF_CTL + 2048;
constexpr int SMEM_BYTES = 73728;
constexpr int P2_SPLIT = 24;

struct Params {
  const float* x; const float* meta; const float* norm_w; const float* w_in;
  const float* lq1; const float* lk1; const float* lq2; const float* lk2;
  const float* attn_norm_w; const float* conv_w; const float* a_log; const float* dt_bias;
  const float* dn_norm_w; const float* w_a; const float* w_d; const float* w_o; const float* final_w;
  float* out; unsigned char* ws;
};

typedef __bf16 bf16x2_t __attribute__((ext_vector_type(2)));
typedef float f32x2_t __attribute__((ext_vector_type(2)));
__device__ __forceinline__ unsigned cvtpk(float lo, float hi) { f32x2_t v = {lo, hi}; bf16x2_t b = __builtin_convertvector(v, bf16x2_t); return __builtin_bit_cast(unsigned, b); }
__device__ __forceinline__ u16 f2bf(float f) { return (u16)(cvtpk(f, 0.f) & 0xffffu); }
__device__ __forceinline__ float bf2f(u16 v) { return __uint_as_float(((unsigned)v) << 16); }
__device__ __forceinline__ float bflo(unsigned v) { return __uint_as_float(v << 16); }
__device__ __forceinline__ float bfhi(unsigned v) { return __uint_as_float(v & 0xffff0000u); }
__device__ __forceinline__ float sigmoidf_(float x) { return 1.f / (1.f + __expf(-x)); }
__device__ __forceinline__ float siluf_(float x) { return x / (1.f + __expf(-x)); }
__device__ __forceinline__ f32x16 mfma32(bf16x8 a, bf16x8 b, f32x16 c) { return __builtin_amdgcn_mfma_f32_32x32x16_bf16(a, b, c, 0, 0, 0); }
__device__ __forceinline__ float wave_sum(float v) {
#pragma unroll
  for (int o = 32; o > 0; o >>= 1) v += __shfl_xor(v, o);
  return v;
}

__device__ __forceinline__ int ltid() { int t = threadIdx.x; asm volatile("" : "+v"(t)); return t; }

__device__ __forceinline__ void lds_barrier() { asm volatile("s_waitcnt lgkmcnt(0)\n\ts_barrier" ::: "memory"); }

__device__ __forceinline__ void grid_barrier(unsigned* ctr, const unsigned k) {
  __syncthreads();
  if (threadIdx.x == 0) {
    __hip_atomic_fetch_add(ctr, 1u, __ATOMIC_RELEASE, __HIP_MEMORY_SCOPE_AGENT);
    const unsigned target = k * gridDim.x;
    while (__hip_atomic_load(ctr, __ATOMIC_RELAXED, __HIP_MEMORY_SCOPE_AGENT) < target) __builtin_amdgcn_s_sleep(1);
    __builtin_amdgcn_fence(__ATOMIC_ACQUIRE, "agent");
  }
  __syncthreads();
}

__device__ __forceinline__ bool tile_map(int i, int xcd, int MT, int NT, int& mt, int& nt) {
  int cm = (MT - xcd + 7) >> 3;
  int ag = i / (8 * NT);
  if (ag * 8 >= cm) return false;
  int gs = cm - ag * 8; if (gs > 8) gs = 8;
  int j = i - ag * 8 * NT;
  if (j >= gs * NT) return false;
  int al = j % gs; nt = j / gs;
  mt = xcd + 8 * (8 * ag + al);
  return true;
}

template <class ARowF, class KOffF>
__device__ __forceinline__ void gemm_kloop(f32x16 (&acc)[2][2], ARowF arow, KOffF koff, const u16* __restrict__ Bt, int m0, int n0, unsigned char* smem) {
  const int tid = ltid(), lane = tid & 63, wave = tid >> 6;
  const int wm = wave >> 1, wn = wave & 1;
  const int lr = tid >> 3, lc = tid & 7;
  const int l31 = lane & 31, hf = lane >> 5;
  u16* sA = (u16*)smem; u16* sB = sA + 2 * 128 * 72;
  const u16* pa0 = arow(m0 + lr) + lc * 8; const u16* pa1 = arow(m0 + lr + 32) + lc * 8;
  const u16* pa2 = arow(m0 + lr + 64) + lc * 8; const u16* pa3 = arow(m0 + lr + 96) + lc * 8;
  const u16* pb0 = Bt + (size_t)(n0 + lr) * 1024 + lc * 8;
  u32x4 ra0, ra1, ra2, ra3, rb0, rb1, rb2, rb3;
  {
    const size_t ko = koff(0);
    ra0 = *(const u32x4*)(pa0 + ko); ra1 = *(const u32x4*)(pa1 + ko); ra2 = *(const u32x4*)(pa2 + ko); ra3 = *(const u32x4*)(pa3 + ko);
    rb0 = *(const u32x4*)(pb0); rb1 = *(const u32x4*)(pb0 + 32 * 1024); rb2 = *(const u32x4*)(pb0 + 64 * 1024); rb3 = *(const u32x4*)(pb0 + 96 * 1024);
  }
  u16* wA0 = sA + lr * 72 + lc * 8; u16* wB0 = sB + lr * 72 + lc * 8;
  *(u32x4*)(wA0) = ra0; *(u32x4*)(wA0 + 32 * 72) = ra1; *(u32x4*)(wA0 + 64 * 72) = ra2; *(u32x4*)(wA0 + 96 * 72) = ra3;
  *(u32x4*)(wB0) = rb0; *(u32x4*)(wB0 + 32 * 72) = rb1; *(u32x4*)(wB0 + 64 * 72) = rb2; *(u32x4*)(wB0 + 96 * 72) = rb3;
  lds_barrier();
#pragma unroll 1
  for (int kt = 0; kt < 16; ++kt) {
    const int buf = kt & 1;
    if (kt + 1 < 16) {
      const size_t ko = koff((kt + 1) * 64); const int kb = (kt + 1) * 64;
      ra0 = *(const u32x4*)(pa0 + ko); ra1 = *(const u32x4*)(pa1 + ko); ra2 = *(const u32x4*)(pa2 + ko); ra3 = *(const u32x4*)(pa3 + ko);
      rb0 = *(const u32x4*)(pb0 + kb); rb1 = *(const u32x4*)(pb0 + 32 * 1024 + kb); rb2 = *(const u32x4*)(pb0 + 64 * 1024 + kb); rb3 = *(const u32x4*)(pb0 + 96 * 1024 + kb);
    }
    const u16* cA = sA + buf * 128 * 72 + (wm * 64 + l31) * 72 + hf * 8;
    const u16* cB = sB + buf * 128 * 72 + (wn * 64 + l31) * 72 + hf * 8;
#pragma unroll
    for (int ks = 0; ks < 4; ++ks) {
      bf16x8 a0 = *(const bf16x8*)(cA + ks * 16);
      bf16x8 a1 = *(const bf16x8*)(cA + 32 * 72 + ks * 16);
      bf16x8 b0 = *(const bf16x8*)(cB + ks * 16);
      bf16x8 b1 = *(const bf16x8*)(cB + 32 * 72 + ks * 16);
      acc[0][0] = mfma32(a0, b0, acc[0][0]);
      acc[0][1] = mfma32(a0, b1, acc[0][1]);
      acc[1][0] = mfma32(a1, b0, acc[1][0]);
      acc[1][1] = mfma32(a1, b1, acc[1][1]);
    }
    if (kt + 1 < 16) {
      u16* wA = wA0 + (buf ^ 1) * 128 * 72; u16* wB = wB0 + (buf ^ 1) * 128 * 72;
      *(u32x4*)(wA) = ra0; *(u32x4*)(wA + 32 * 72) = ra1; *(u32x4*)(wA + 64 * 72) = ra2; *(u32x4*)(wA + 96 * 72) = ra3;
      *(u32x4*)(wB) = rb0; *(u32x4*)(wB + 32 * 72) = rb1; *(u32x4*)(wB + 64 * 72) = rb2; *(u32x4*)(wB + 96 * 72) = rb3;
    }
    lds_barrier();
  }
}

__device__ __forceinline__ void stage_acc(f32x16 (&acc)[2][2], float* sC) {
  const int tid__ = ltid(); const int lane = tid__ & 63, wave = tid__ >> 6;
  const int wm = wave >> 1, wn = wave & 1, l31 = lane & 31, hf = lane >> 5;
  float* base = sC + (wm * 64 + 4 * hf) * 132 + wn * 64 + l31;
#pragma unroll
  for (int mi = 0; mi < 2; ++mi)
#pragma unroll
    for (int ni = 0; ni < 2; ++ni)
#pragma unroll
      for (int r = 0; r < 16; ++r) base[(mi * 32 + 8 * (r >> 2) + (r & 3)) * 132 + ni * 32] = acc[mi][ni][r];
  __syncthreads();
}
template <class Epi>
__device__ __forceinline__ void epilogue_rows(f32x16 (&acc)[2][2], int m0, int n0, unsigned char* smem, Epi epi) {
  float* sC = (float*)smem;
  stage_acc(acc, sC);
  const int tid = ltid();
#pragma unroll 2
  for (int it = 0; it < 8; ++it) {
    int idx = tid + 256 * it; int r = idx >> 4, c8 = (idx & 15) * 8;
    float4 a = *(const float4*)(sC + r * 132 + c8), b = *(const float4*)(sC + r * 132 + c8 + 4);
    epi(m0 + r, n0 + c8, a, b);
  }
  __syncthreads();
}
template <class Epi>
__device__ __forceinline__ void epilogue_cols(f32x16 (&acc)[2][2], int m0, int n0, unsigned char* smem, Epi epi) {
  float* sC = (float*)smem;
  stage_acc(acc, sC);
  const int tid = ltid();
#pragma unroll 2
  for (int it = 0; it < 8; ++it) {
    int idx = tid + 256 * it; int n = idx & 127, r8 = (idx >> 7) * 8;
    const float* s = sC + r8 * 132 + n;
    float4 a = make_float4(s[0], s[132], s[264], s[396]), b = make_float4(s[528], s[660], s[792], s[924]);
    epi(m0 + r8, n0 + n, a, b);
  }
  __syncthreads();
}
__device__ __forceinline__ uint4 pack8(float4 a, float4 b) { uint4 o; o.x = cvtpk(a.x, a.y); o.y = cvtpk(a.z, a.w); o.z = cvtpk(b.x, b.y); o.w = cvtpk(b.z, b.w); return o; }

__device__ __forceinline__ void zero_acc(f32x16 (&acc)[2][2]) {
#pragma unroll
  for (int a = 0; a < 2; ++a)
#pragma unroll
    for (int b = 0; b < 2; ++b)
#pragma unroll
      for (int r = 0; r < 16; ++r) acc[a][b][r] = 0.f;
}

__device__ __forceinline__ void phase0(const Params& p, unsigned char* smem) {
  u16* hn = (u16*)p.out; u16* wtin = hn + (size_t)NTOK * DM;
  u16* w3 = (u16*)(p.ws + OFF_W3);
  const int tid = ltid(), lane = tid & 63, wave = tid >> 6;
  constexpr int N_HN = NTOK / 4;
  constexpr int NT_IN = 161;
  constexpr int N_TR = 16 * NT_IN + 3 * 256;
  constexpr int N_MISC = 16;
  for (int it = blockIdx.x; it < N_HN + N_TR + N_MISC; it += gridDim.x) {
    if (it < N_HN) {
      int row = it * 4 + wave; int b = row / LTOK, pos = row - b * LTOK;
      const float* src = pos < NMETA ? p.meta + pos * DM : p.x + ((size_t)b * SEQ + pos - NMETA) * DM;
      float4 v[4]; float ss = 0.f;
#pragma unroll
      for (int i = 0; i < 4; ++i) { v[i] = ((const float4*)src)[lane + 64 * i]; ss += v[i].x * v[i].x + v[i].y * v[i].y + v[i].z * v[i].z + v[i].w * v[i].w; }
      ss = wave_sum(ss);
      float rs = rsqrtf(ss * (1.f / 1024.f) + 1e-6f);
#pragma unroll
      for (int i = 0; i < 4; ++i) {
        float4 w = ((const float4*)p.norm_w)[lane + 64 * i];
        uint2 o; o.x = cvtpk(v[i].x * rs * w.x, v[i].y * rs * w.y); o.y = cvtpk(v[i].z * rs * w.z, v[i].w * rs * w.w);
        ((uint2*)(hn + (size_t)row * DM))[lane + 64 * i] = o;
      }
    } else if (it < N_HN + N_TR) {
      int j = it - N_HN; const float* W; u16* Wt; int N, kt, nt;
      if (j < 16 * NT_IN) { W = p.w_in; Wt = wtin; N = INDIM; kt = j / NT_IN; nt = j - kt * NT_IN; }
      else { j -= 16 * NT_IN; int mtx = j >> 8; j &= 255; W = mtx == 0 ? p.w_a : (mtx == 1 ? p.w_d : p.w_o); Wt = w3 + (size_t)mtx * 1024 * 1024; N = 1024; kt = j >> 4; nt = j & 15; }
      float* tile = (float*)smem;
#pragma unroll
      for (int i = 0; i < 16; ++i) {
        int k = (tid >> 6) + 4 * i; int n = nt * 64 + (tid & 63);
        tile[k * 65 + (tid & 63)] = n < N ? W[(size_t)(kt * 64 + k) * N + n] : 0.f;
      }
      __syncthreads();
      int kk2 = (tid & 31) * 2;
#pragma unroll
      for (int i = 0; i < 8; ++i) {
        int jj = (tid >> 5) + 8 * i; int n = nt * 64 + jj;
        if (n < N) *(unsigned*)(Wt + (size_t)n * 1024 + kt * 64 + kk2) = cvtpk(tile[kk2 * 65 + jj], tile[(kk2 + 1) * 65 + jj]);
      }
      __syncthreads();
    } else {
      int mi = it - N_HN - N_TR;
      unsigned* ak = (unsigned*)(p.ws + OFF_AK); unsigned* avt = (unsigned*)(p.ws + OFF_AVT);
      for (int idx = mi * 256 + tid; idx < 2 * 48 * 512; idx += N_MISC * 256) {
        int b = idx / (48 * 512), r = idx - b * 48 * 512;
        ak[((size_t)b * LPAD + LTOK) * 512 + r] = 0u;
      }
      for (int idx = mi * 256 + tid; idx < 2048 * 24; idx += N_MISC * 256) {
        int row = idx / 24, c = idx - row * 24;
        avt[(size_t)row * (LPAD / 2) + LTOK / 2 + c] = 0u;
      }
      if (mi == 0) {
        int* ctl = (int*)(p.ws + OFF_CTL);
        if (tid < 16) ctl[tid] = 0;
        if (wave == 1) {
          float a = p.lq1[lane] * p.lk1[lane], c = p.lq2[lane] * p.lk2[lane];
          a = wave_sum(a); c = wave_sum(c);
          if (lane == 0) ((float*)ctl)[16] = __expf(a) - __expf(c) + 0.2f;
        }
      }
    }
  }
}

__device__ __forceinline__ void phase1(const Params& p, unsigned char* smem) {
  const u16* hn = (const u16*)p.out; const u16* wtin = hn + (size_t)NTOK * DM;
  u16* AQ = (u16*)(p.ws + OFF_AQ); u16* AK = (u16*)(p.ws + OFF_AK); u16* AVT = (u16*)(p.ws + OFF_AVT);
  u16* DX = (u16*)(p.ws + OFF_DX); u16* HALO = (u16*)(p.ws + OFF_HALO);
  float* BETA = (float*)(p.ws + OFF_BETA); float* GG = (float*)(p.ws + OFF_G);
  const int xcd = blockIdx.x & 7, lw = blockIdx.x >> 3, LW = (gridDim.x - xcd + 7) >> 3;
  for (int i = lw;; i += LW) {
    int mt, nt; if (!tile_map(i, xcd, 129, 49, mt, nt)) break;
    const int m0 = mt * 128;
    const int n0 = nt < 24 ? nt * 128 : (nt < 48 ? 4096 + (nt - 24) * 128 : 8192);
    f32x16 acc[2][2]; zero_acc(acc);
    gemm_kloop(acc, [&](int m) { int mm = m < NTOK ? m : NTOK - 1; return hn + (size_t)mm * DM; }, [](int k0) { return (size_t)k0; }, wtin, m0, n0, smem);
    if (nt < 8) {
      epilogue_rows(acc, m0, n0, smem, [&](int m, int n, float4 a, float4 b) {
        if (m < NTOK) {
          a.x *= QSCALE; a.y *= QSCALE; a.z *= QSCALE; a.w *= QSCALE; b.x *= QSCALE; b.y *= QSCALE; b.z *= QSCALE; b.w *= QSCALE;
          *(uint4*)(AQ + (size_t)m * 1024 + n) = pack8(a, b);
        }
      });
    } else if (nt < 16) {
      epilogue_rows(acc, m0, n0, smem, [&](int m, int n, float4 a, float4 b) {
        if (m < NTOK) { int bb = m / LTOK, pos = m - bb * LTOK; *(uint4*)(AK + ((size_t)bb * LPAD + pos) * 1024 + (n - 1024)) = pack8(a, b); }
      });
    } else if (nt < 24) {
      epilogue_cols(acc, m0, n0, smem, [&](int m, int n, float4 a, float4 b) {
        if (m < NTOK) { int bb = m / LTOK, pos = m - bb * LTOK; *(uint4*)(AVT + ((size_t)(bb * 1024 + (n - 2048))) * LPAD + pos) = pack8(a, b); }
      });
    } else if (nt < 48) {
      epilogue_rows(acc, m0, n0, smem, [&](int m, int n, float4 a, float4 b) {
        if (m < NTOK) {
          int nn = n - 4096; int which = nn >> 10; int h = (nn >> 7) & 7; int d = nn & 127;
          int bb = m / LTOK, pos = m - bb * LTOK; int pp = pos + 48; int c = pp >> 6, rr = pp & 63;
          size_t blk = ((size_t)((bb * 8 + h) * NCH + c)) * 3 + which;
          uint4 o = pack8(a, b);
          *(uint4*)(DX + blk * 8192 + rr * 128 + d) = o;
          if (rr >= 61) *(uint4*)(HALO + blk * 384 + (rr - 61) * 128 + d) = o;
        }
      });
    } else {
      epilogue_rows(acc, m0, n0, smem, [&](int m, int n, float4 a, float4 b) {
        if (m < NTOK && n < 8208) {
          int isg = n >= 8200;
          int bb = m / LTOK, pos = m - bb * LTOK;
          float v[8] = {a.x, a.y, a.z, a.w, b.x, b.y, b.z, b.w};
#pragma unroll
          for (int h = 0; h < 8; ++h) {
            size_t o = (size_t)(bb * 8 + h) * LPAD + pos + 48;
            if (!isg) BETA[o] = sigmoidf_(v[h]);
            else { float z = v[h] + p.dt_bias[h]; float sp = z > 20.f ? z : log1pf(__expf(z)); GG[o] = -__expf(p.a_log[h]) * sp; }
          }
        }
      });
    }
  }
}

__device__ __forceinline__ void phase2(const Params& p, unsigned char* smem, const int lo, const int hi, const int worker, const int nworkers) {
  u16* DX = (u16*)(p.ws + OFF_DX); const u16* HALO = (const u16*)(p.ws + OFF_HALO);
  const float* BETA = (const float*)(p.ws + OFF_BETA); const float* GG = (const float*)(p.ws + OFF_G);
  u16* TA = (u16*)(p.ws + OFF_EXTRA);
  float* sin = (float*)smem;
  u16* sq = (u16*)(smem + 34304);
  u16* sk = sq + 64 * 136;
  u16* svT = sq;
  float* sgc = (float*)(smem + 34304 + 34816);
  float* sbeta = sgc + 64;
  float* sM = (float*)smem;
  const int tid = ltid(), lane = tid & 63, wave = tid >> 6;
  const int l31 = lane & 31, hf = lane >> 5;
  for (int idx2 = lo + worker; idx2 < hi; idx2 += nworkers) {
    const int bh = idx2 & 15, c = idx2 >> 4; const int it = bh * NCH + c; const int h = bh & 7;
    if (wave == 0) {
      const bool pad = (c == 0 && lane < 48);
      float g = pad ? 0.f : GG[(size_t)bh * LPAD + c * 64 + lane];
      float be = pad ? 0.f : BETA[(size_t)bh * LPAD + c * 64 + lane];
#pragma unroll
      for (int o = 1; o < 64; o <<= 1) { float t = __shfl_up(g, o); if (lane >= o) g += t; }
      sgc[lane] = g; sbeta[lane] = be;
    }
    for (int wi = 0; wi < 3; ++wi) {
      const int which = wi == 0 ? 2 : wi - 1;
      u16* X = DX + ((size_t)it * 3 + which) * 8192;
      const u16* H = HALO + ((size_t)(it - 1) * 3 + which) * 384;
      {
        u32x4 ld[5];
#pragma unroll
        for (int i = 0; i < 5; ++i) {
          const int idx = tid + 256 * i; const int rr = idx >> 4, c8 = (idx & 15) * 8; const int r = rr - 3;
          const bool zero = (idx >= 67 * 16) || (c == 0 && r < 48);
          const u16* srcp = (r < 0) ? (H + rr * 128 + c8) : (X + r * 128 + c8);
          u32x4 z = {0u, 0u, 0u, 0u};
          ld[i] = zero ? z : *(const u32x4*)srcp;
        }
#pragma unroll
        for (int i = 0; i < 5; ++i) {
          const int idx = tid + 256 * i; const int rr = idx >> 4, c8 = (idx & 15) * 8;
          if (idx < 67 * 16) {
            float4 a = make_float4(bflo(ld[i].x), bfhi(ld[i].x), bflo(ld[i].y), bfhi(ld[i].y));
            float4 b = make_float4(bflo(ld[i].z), bfhi(ld[i].z), bflo(ld[i].w), bfhi(ld[i].w));
            *(float4*)(sin + rr * 128 + c8) = a; *(float4*)(sin + rr * 128 + c8 + 4) = b;
          }
        }
      }
      __syncthreads();
      const int d0 = 2 * lane; const int ch = which * 1024 + h * 128 + d0;
      float w0[4], w1[4];
#pragma unroll
      for (int j = 0; j < 4; ++j) { w0[j] = p.conv_w[j * 3072 + ch]; w1[j] = p.conv_w[j * 3072 + ch + 1]; }
      for (int rb = 0; rb < 4; ++rb) {
        float y0[4], y1[4];
#pragma unroll
        for (int u = 0; u < 4; ++u) {
          const int r = wave * 16 + rb * 4 + u;
          float a0 = 0.f, a1 = 0.f;
#pragma unroll
          for (int j = 0; j < 4; ++j) { float2 xv = *(const float2*)(sin + (r + j) * 128 + d0); a0 += w0[j] * xv.x; a1 += w1[j] * xv.y; }
          y0[u] = siluf_(a0); y1[u] = siluf_(a1);
        }
        if (which < 2) {
          float ss[4];
#pragma unroll
          for (int u = 0; u < 4; ++u) ss[u] = y0[u] * y0[u] + y1[u] * y1[u];
#pragma unroll
          for (int o = 32; o > 0; o >>= 1) {
#pragma unroll
            for (int u = 0; u < 4; ++u) ss[u] += __shfl_xor(ss[u], o);
          }
#pragma unroll
          for (int u = 0; u < 4; ++u) {
            const int r = wave * 16 + rb * 4 + u;
            const bool pad = (c == 0 && r < 48);
            float sc = rsqrtf(ss[u] + 1e-6f) * (which == 0 ? 0.08838834764831845f : 1.f);
            if (pad) sc = 0.f;
            unsigned pk = cvtpk(y0[u] * sc, y1[u] * sc);
            *(unsigned*)(X + r * 128 + d0) = pk;
            *(unsigned*)((which == 0 ? sq : sk) + r * 136 + d0) = pk;
          }
        } else {
#pragma unroll
          for (int u = 0; u < 4; ++u) {
            const int r = wave * 16 + rb * 4 + u;
            const bool pad = (c == 0 && r < 48);
            float be = pad ? 0.f : sbeta[r];
            svT[d0 * 72 + r] = f2bf(y0[u] * be); svT[(d0 + 1) * 72 + r] = f2bf(y1[u] * be);
          }
        }
      }
      __syncthreads();
      if (which == 2) {
#pragma unroll
        for (int i = 0; i < 4; ++i) { int idx = tid + 256 * i; int e = idx >> 3, c8 = (idx & 7) * 8; *(uint4*)(X + e * 64 + c8) = *(const uint4*)(svT + e * 72 + c8); }
      }
    }
    const int ti = wave >> 1, tj = wave & 1;
    f32x16 kk, qk;
#pragma unroll
    for (int r = 0; r < 16; ++r) { kk[r] = 0.f; qk[r] = 0.f; }
#pragma unroll
    for (int s = 0; s < 8; ++s) {
      bf16x8 bj = *(const bf16x8*)(sk + (32 * tj + l31) * 136 + s * 16 + hf * 8);
      bf16x8 ak = *(const bf16x8*)(sk + (32 * ti + l31) * 136 + s * 16 + hf * 8);
      bf16x8 aq = *(const bf16x8*)(sq + (32 * ti + l31) * 136 + s * 16 + hf * 8);
      kk = mfma32(ak, bj, kk); qk = mfma32(aq, bj, qk);
    }
    __syncthreads();
    u16* Tg = TA + (size_t)it * 8704; u16* Ag = Tg + 4096; float* SCg = (float*)(Tg + 8192);
    {
      const int j = 32 * tj + l31; const float gcj = sgc[j];
#pragma unroll
      for (int r = 0; r < 16; ++r) {
        const int i = 32 * ti + 8 * (r >> 2) + 4 * hf + (r & 3);
        const float gci = sgc[i]; const float bi = sbeta[i];
        const float dec = __expf(gci - gcj);
        sM[i * 68 + j] = (j < i) ? bi * kk[r] * dec : 0.f;
        Ag[i * 64 + j] = f2bf((j <= i) ? qk[r] * dec : 0.f);
      }
    }
    __syncthreads();
    float* sTc = (float*)sq;
    if (wave == 0) {
      float* mycol = sTc + lane * 68;
#pragma unroll 1
      for (int blk = 0; blk < 4; ++blk) {
        const int r0 = blk * 16;
        float acc[16];
#pragma unroll
        for (int r = 0; r < 16; ++r) acc[r] = 0.f;
#pragma unroll 1
        for (int j = 0; j < r0; j += 4) {
          const float4 t4 = *(const float4*)(mycol + j);
#pragma unroll
          for (int r = 0; r < 16; ++r) {
            const float4 m4 = *(const float4*)(sM + (r0 + r) * 68 + j);
            acc[r] += (m4.x * t4.x + m4.y * t4.y) + (m4.z * t4.z + m4.w * t4.w);
          }
        }
        float tt[16];
#pragma unroll
        for (int r = 0; r < 16; ++r) {
          float s = acc[r];
#pragma unroll
          for (int q4 = 0; q4 < r; q4 += 4) {
            const float4 m4 = *(const float4*)(sM + (r0 + r) * 68 + r0 + q4);
            s += m4.x * tt[q4];
            if (q4 + 1 < r) s += m4.y * tt[q4 + 1];
            if (q4 + 2 < r) s += m4.z * tt[q4 + 2];
            if (q4 + 3 < r) s += m4.w * tt[q4 + 3];
          }
          tt[r] = ((r0 + r == lane) ? 1.f : 0.f) - s;
        }
#pragma unroll
        for (int r = 0; r < 16; r += 4) *(float4*)(mycol + r0 + r) = make_float4(tt[r], tt[r + 1], tt[r + 2], tt[r + 3]);
      }
    }
    __syncthreads();
#pragma unroll
    for (int i = 0; i < 2; ++i) {
      int idx = tid + 256 * i; int r = idx >> 3, c8 = (idx & 7) * 8; const float* s = sTc + c8 * 68 + r;
      uint4 o; o.x = cvtpk(s[0], s[68]); o.y = cvtpk(s[136], s[204]); o.z = cvtpk(s[272], s[340]); o.w = cvtpk(s[408], s[476]);
      *(uint4*)(Tg + r * 64 + c8) = o;
    }
    if (tid < 64) {
      float gc = sgc[tid], be = sbeta[tid]; float eg = __expf(gc);
      SCg[tid] = be; SCg[64 + tid] = be * eg; SCg[128 + tid] = eg; SCg[192 + tid] = __expf(sgc[63] - gc);
    }
    __syncthreads();
  }
}

__device__ __forceinline__ bf16x8 mk8(uint2 lo, uint2 hi) { u32x4 t = {lo.x, lo.y, hi.x, hi.y}; return __builtin_bit_cast(bf16x8, t); }

__device__ __forceinline__ void scan_chunked(const Params& p, unsigned char* smem, int bh, f32x16 (&S)[4], const int c_begin, const int c_end) {
  u16* DX = (u16*)(p.ws + OFF_DX); const u16* TA = (const u16*)(p.ws + OFF_EXTRA);
  const int tid = ltid(), lane = tid & 63, wave = tid >> 6;
  const int l31 = lane & 31, hf = lane >> 5;
  u16* sk = (u16*)smem;
  u16* sq = sk + 64 * 136;
  u16* sT = sq + 64 * 136;
  u16* sA = sT + 64 * 72;
  float* sSC = (float*)(sA + 64 * 72);
  u32x4 pk[4], pq[4], pT[2], pA[2]; uint2 pv[8]; float psc;
#pragma unroll 1
  for (int c = c_begin; c < c_end; ++c) {
    {
      const u16* Xq = DX + ((size_t)(bh * NCH + c) * 3) * 8192; const u16* Xk = Xq + 8192; const u16* Xv = Xk + 8192;
      const u16* Tg = TA + (size_t)(bh * NCH + c) * 8704; const u16* Ag = Tg + 4096;
#pragma unroll
      for (int i = 0; i < 4; ++i) { pk[i] = *(const u32x4*)(Xk + (tid + 256 * i) * 8); pq[i] = *(const u32x4*)(Xq + (tid + 256 * i) * 8); }
#pragma unroll
      for (int i = 0; i < 2; ++i) { pT[i] = *(const u32x4*)(Tg + (tid + 256 * i) * 8); pA[i] = *(const u32x4*)(Ag + (tid + 256 * i) * 8); }
      psc = ((const float*)(Tg + 8192))[tid];
#pragma unroll
      for (int i = 0; i < 8; ++i) pv[i] = *(const uint2*)(Xv + (wave * 32 + l31) * 64 + 32 * (i >> 2) + 8 * (i & 3) + 4 * hf);
    }
#pragma unroll
    for (int i = 0; i < 4; ++i) {
      int idx = tid + 256 * i; int row = idx >> 4, ch = idx & 15; const int po = (ch >> 1) * 16 + (ch & 1) * 4;
      u16* dk = sk + row * 136 + po; *(uint2*)dk = make_uint2(pk[i].x, pk[i].y); *(uint2*)(dk + 8) = make_uint2(pk[i].z, pk[i].w);
      u16* dq = sq + row * 136 + po; *(uint2*)dq = make_uint2(pq[i].x, pq[i].y); *(uint2*)(dq + 8) = make_uint2(pq[i].z, pq[i].w);
    }
#pragma unroll
    for (int i = 0; i < 2; ++i) {
      int idx = tid + 256 * i; int row = idx >> 3, ch = idx & 7; const int po = (ch >> 1) * 16 + (ch & 1) * 4;
      u16* dt = sT + row * 72 + po; *(uint2*)dt = make_uint2(pT[i].x, pT[i].y); *(uint2*)(dt + 8) = make_uint2(pT[i].z, pT[i].w);
      u16* da = sA + row * 72 + po; *(uint2*)da = make_uint2(pA[i].x, pA[i].y); *(uint2*)(da + 8) = make_uint2(pA[i].z, pA[i].w);
    }
    sSC[tid] = psc;
    lds_barrier();
    __builtin_amdgcn_sched_barrier(0);
    u32x4 yf[4];
    {
      f32x16 x0, x1;
#pragma unroll
      for (int r = 0; r < 16; ++r) { x0[r] = 0.f; x1[r] = 0.f; }
#pragma unroll
      for (int dt = 0; dt < 4; ++dt)
#pragma unroll
        for (int s = 0; s < 2; ++s) {
          u32x4 sb = {cvtpk(S[dt][8 * s + 0], S[dt][8 * s + 1]), cvtpk(S[dt][8 * s + 2], S[dt][8 * s + 3]), cvtpk(S[dt][8 * s + 4], S[dt][8 * s + 5]), cvtpk(S[dt][8 * s + 6], S[dt][8 * s + 7])};
          const bf16x8 k0f = *(const bf16x8*)(sk + (l31) * 136 + 32 * dt + 16 * s + 8 * hf);
          const bf16x8 k1f = *(const bf16x8*)(sk + (32 + l31) * 136 + 32 * dt + 16 * s + 8 * hf);
          x0 = mfma32(k0f, __builtin_bit_cast(bf16x8, sb), x0);
          x1 = mfma32(k1f, __builtin_bit_cast(bf16x8, sb), x1);
        }
#pragma unroll
      for (int g = 0; g < 4; ++g) {
        {
          float4 bg4 = *(const float4*)(sSC + 64 + 8 * g + 4 * hf);
          uint2 vb = pv[g];
          yf[(g >> 1)][(g & 1) * 2 + 0] = cvtpk(bflo(vb.x) - bg4.x * x0[4 * g + 0], bfhi(vb.x) - bg4.y * x0[4 * g + 1]);
          yf[(g >> 1)][(g & 1) * 2 + 1] = cvtpk(bflo(vb.y) - bg4.z * x0[4 * g + 2], bfhi(vb.y) - bg4.w * x0[4 * g + 3]);
        }
        {
          float4 bg4 = *(const float4*)(sSC + 64 + 32 + 8 * g + 4 * hf);
          uint2 vb = pv[4 + g];
          yf[2 + (g >> 1)][(g & 1) * 2 + 0] = cvtpk(bflo(vb.x) - bg4.x * x1[4 * g + 0], bfhi(vb.x) - bg4.y * x1[4 * g + 1]);
          yf[2 + (g >> 1)][(g & 1) * 2 + 1] = cvtpk(bflo(vb.y) - bg4.z * x1[4 * g + 2], bfhi(vb.y) - bg4.w * x1[4 * g + 3]);
        }
      }
    }
    __builtin_amdgcn_sched_barrier(0);
    u32x4 vnf[4];
    {
      f32x16 v0, v1;
#pragma unroll
      for (int r = 0; r < 16; ++r) { v0[r] = 0.f; v1[r] = 0.f; }
#pragma unroll
      for (int s = 0; s < 4; ++s) {
        const bf16x8 t0f = *(const bf16x8*)(sT + (l31) * 72 + 16 * s + 8 * hf);
        const bf16x8 t1f = *(const bf16x8*)(sT + (32 + l31) * 72 + 16 * s + 8 * hf);
        v0 = mfma32(t0f, __builtin_bit_cast(bf16x8, yf[s]), v0);
        v1 = mfma32(t1f, __builtin_bit_cast(bf16x8, yf[s]), v1);
      }
#pragma unroll
      for (int g = 0; g < 4; ++g) {
        vnf[(g >> 1)][(g & 1) * 2 + 0] = cvtpk(v0[4 * g + 0], v0[4 * g + 1]);
        vnf[(g >> 1)][(g & 1) * 2 + 1] = cvtpk(v0[4 * g + 2], v0[4 * g + 3]);
        vnf[2 + (g >> 1)][(g & 1) * 2 + 0] = cvtpk(v1[4 * g + 0], v1[4 * g + 1]);
        vnf[2 + (g >> 1)][(g & 1) * 2 + 1] = cvtpk(v1[4 * g + 2], v1[4 * g + 3]);
      }
    }
    __builtin_amdgcn_sched_barrier(0);
    u16* Oq = DX + ((size_t)(bh * NCH + c) * 3) * 8192;
    {
      f32x16 o0, o1;
#pragma unroll
      for (int r = 0; r < 16; ++r) { o0[r] = 0.f; o1[r] = 0.f; }
#pragma unroll
      for (int dt = 0; dt < 4; ++dt)
#pragma unroll
        for (int s = 0; s < 2; ++s) {
          u32x4 sb = {cvtpk(S[dt][8 * s + 0], S[dt][8 * s + 1]), cvtpk(S[dt][8 * s + 2], S[dt][8 * s + 3]), cvtpk(S[dt][8 * s + 4], S[dt][8 * s + 5]), cvtpk(S[dt][8 * s + 6], S[dt][8 * s + 7])};
          const bf16x8 q0f = *(const bf16x8*)(sq + (l31) * 136 + 32 * dt + 16 * s + 8 * hf);
          const bf16x8 q1f = *(const bf16x8*)(sq + (32 + l31) * 136 + 32 * dt + 16 * s + 8 * hf);
          o0 = mfma32(q0f, __builtin_bit_cast(bf16x8, sb), o0);
          o1 = mfma32(q1f, __builtin_bit_cast(bf16x8, sb), o1);
        }
#pragma unroll
      for (int g = 0; g < 4; ++g) {
        float4 e0 = *(const float4*)(sSC + 128 + 8 * g + 4 * hf), e1 = *(const float4*)(sSC + 128 + 32 + 8 * g + 4 * hf);
        o0[4 * g + 0] *= e0.x; o0[4 * g + 1] *= e0.y; o0[4 * g + 2] *= e0.z; o0[4 * g + 3] *= e0.w;
        o1[4 * g + 0] *= e1.x; o1[4 * g + 1] *= e1.y; o1[4 * g + 2] *= e1.z; o1[4 * g + 3] *= e1.w;
      }
#pragma unroll
      for (int s = 0; s < 4; ++s) {
        const bf16x8 a0f = *(const bf16x8*)(sA + (l31) * 72 + 16 * s + 8 * hf);
        const bf16x8 a1f = *(const bf16x8*)(sA + (32 + l31) * 72 + 16 * s + 8 * hf);
        o0 = mfma32(a0f, __builtin_bit_cast(bf16x8, vnf[s]), o0);
        o1 = mfma32(a1f, __builtin_bit_cast(bf16x8, vnf[s]), o1);
      }
#pragma unroll
      for (int r = 0; r < 16; ++r) {
        Oq[(8 * (r >> 2) + 4 * hf + (r & 3)) * 128 + wave * 32 + l31] = f2bf(o0[r]);
        Oq[(32 + 8 * (r >> 2) + 4 * hf + (r & 3)) * 128 + wave * 32 + l31] = f2bf(o1[r]);
      }
    }
    __builtin_amdgcn_sched_barrier(0);
    const float cd = sSC[128 + 63];
#pragma unroll
    for (int dt = 0; dt < 4; ++dt)
#pragma unroll
      for (int r = 0; r < 16; ++r) S[dt][r] *= cd;
    u32x4 vs[4];
#pragma unroll
    for (int s = 0; s < 4; ++s) {
      const float4 e0 = *(const float4*)(sSC + 192 + 16 * s + 4 * hf), e1 = *(const float4*)(sSC + 192 + 16 * s + 8 + 4 * hf);
      vs[s].x = cvtpk(bflo(vnf[s].x) * e0.x, bfhi(vnf[s].x) * e0.y); vs[s].y = cvtpk(bflo(vnf[s].y) * e0.z, bfhi(vnf[s].y) * e0.w);
      vs[s].z = cvtpk(bflo(vnf[s].z) * e1.x, bfhi(vnf[s].z) * e1.y); vs[s].w = cvtpk(bflo(vnf[s].w) * e1.z, bfhi(vnf[s].w) * e1.w);
    }
    {
      u32x4 id1 = {0u, 0u, 0u, 0u}, id2 = {0u, 0u, 0u, 0u};
      {
        const int l15 = l31 & 15;
        const int jsel = (((l15 >> 2) & 1) == hf) ? (4 * (l15 >> 3) + (l15 & 3)) : -1;
        const int j1 = (l31 < 16) ? jsel : -1;
        const int j2 = (l31 >= 16) ? jsel : -1;
        const unsigned one_lo = 0x3f80u, one_hi = 0x3f800000u;
#pragma unroll
        for (int w = 0; w < 4; ++w) {
          id1[w] = (j1 == 2 * w) ? one_lo : ((j1 == 2 * w + 1) ? one_hi : 0u);
          id2[w] = (j2 == 2 * w) ? one_lo : ((j2 == 2 * w + 1) ? one_hi : 0u);
        }
      }
      const bf16x8 B1 = __builtin_bit_cast(bf16x8, id1), B2 = __builtin_bit_cast(bf16x8, id2);
#pragma unroll
      for (int dt = 0; dt < 4; ++dt)
#pragma unroll
        for (int mt = 0; mt < 2; ++mt) {
          f32x16 kt;
#pragma unroll
          for (int r = 0; r < 16; ++r) kt[r] = 0.f;
          const u16* k0 = sk + (32 * mt + l31) * 136 + 32 * dt + 8 * hf;
          kt = mfma32(*(const bf16x8*)(k0), B1, kt);
          kt = mfma32(*(const bf16x8*)(k0 + 16), B2, kt);
#pragma unroll
          for (int s2 = 0; s2 < 2; ++s2) {
            u32x4 af = {cvtpk(kt[8 * s2 + 0], kt[8 * s2 + 1]), cvtpk(kt[8 * s2 + 2], kt[8 * s2 + 3]), cvtpk(kt[8 * s2 + 4], kt[8 * s2 + 5]), cvtpk(kt[8 * s2 + 6], kt[8 * s2 + 7])};
            S[dt] = mfma32(__builtin_bit_cast(bf16x8, af), __builtin_bit_cast(bf16x8, vs[2 * mt + s2]), S[dt]);
          }
        }
    }
    lds_barrier();
  }
}

__device__ __forceinline__ void attn_item(const Params& p, unsigned char* smem, int b, int h, int qb, float lam) {
  int tid_ = ltid();
  const int tid = tid_, lane = tid & 63, wave = tid >> 6;
  const int l31 = lane & 31, hf = lane >> 5;
  const int map = wave >> 1, r0 = (wave & 1) * 32;
  u16* AQ = (u16*)(p.ws + OFF_AQ); const u16* AK = (const u16*)(p.ws + OFF_AK); const u16* AVT = (const u16*)(p.ws + OFF_AVT);
  u16* sK = (u16*)smem;
  float* sO = (float*)smem;
  const int t0 = qb * 64; const int ntiles = qb + 2;
  const size_t qrow = (size_t)(b * LTOK + NMETA + t0 + r0 + l31);
  bf16x8 qf[4];
#pragma unroll
  for (int s = 0; s < 4; ++s) qf[s] = *(const bf16x8*)(AQ + qrow * 1024 + h * 128 + map * 64 + s * 16 + hf * 8);
  f32x16 oacc[4];
#pragma unroll
  for (int d = 0; d < 4; ++d)
#pragma unroll
    for (int r = 0; r < 16; ++r) oacc[d][r] = 0.f;
  float m_run = -1e30f, l_run = 0.f;
  const int qpos = NMETA + t0 + r0 + l31;
  const u16* kbase = AK + ((size_t)b * LPAD) * 1024 + h * 128;
  const u16* vbase = AVT + ((size_t)(b * 8 + h) * 128) * LPAD;
  const int kc = tid & 15, kr = tid >> 4;
  const int vc = tid & 7, vr = tid >> 3;
  u32x4 ak[4], av[4], bk[4], bv[4];
  auto gload = [&](u32x4 (&rk)[4], u32x4 (&rv)[4], int kt) {
#pragma unroll
    for (int i = 0; i < 4; ++i) {
      rk[i] = *(const u32x4*)(kbase + (size_t)(kt * 64 + kr + 16 * i) * 1024 + kc * 8);
      rv[i] = *(const u32x4*)(vbase + (size_t)(vr + 32 * i) * LPAD + kt * 64 + vc * 8);
    }
  };
  auto swrite = [&](const u32x4 (&rk)[4], const u32x4 (&rv)[4], int buf) {
    u16* bK = sK + buf * 17920; u16* bV = bK + 64 * 136;
#pragma unroll
    for (int i = 0; i < 4; ++i) {
      *(u32x4*)(bK + (kr + 16 * i) * 136 + kc * 8) = rk[i];
      u16* dst = bV + (vr + 32 * i) * 72 + (vc >> 1) * 16 + (vc & 1) * 4;
      *(uint2*)dst = make_uint2(rv[i].x, rv[i].y); *(uint2*)(dst + 8) = make_uint2(rv[i].z, rv[i].w);
    }
  };
  auto compute = [&](int kt, int buf) {
    const u16* bK = sK + buf * 17920; const u16* bV = bK + 64 * 136;
    f32x16 st[2];
#pragma unroll
    for (int mt = 0; mt < 2; ++mt) {
#pragma unroll
      for (int r = 0; r < 16; ++r) st[mt][r] = 0.f;
#pragma unroll
      for (int s = 0; s < 4; ++s) {
        bf16x8 kf = *(const bf16x8*)(bK + (mt * 32 + l31) * 136 + map * 64 + s * 16 + hf * 8);
        st[mt] = mfma32(kf, qf[s], st[mt]);
      }
    }
    if (kt >= ntiles - 2) {
#pragma unroll
      for (int mt = 0; mt < 2; ++mt)
#pragma unroll
        for (int r = 0; r < 16; ++r) {
          int key = kt * 64 + mt * 32 + 8 * (r >> 2) + 4 * hf + (r & 3);
          if (key > qpos) st[mt][r] = -1e30f;
        }
    }
    float mx = -1e30f;
#pragma unroll
    for (int mt = 0; mt < 2; ++mt)
#pragma unroll
      for (int r = 0; r < 16; ++r) mx = fmaxf(mx, st[mt][r]);
    mx = fmaxf(mx, __shfl_xor(mx, 32));
    const float m_new = fmaxf(m_run, mx);
    const float alpha = __builtin_amdgcn_exp2f(m_run - m_new);
    float rsum = 0.f;
#pragma unroll
    for (int mt = 0; mt < 2; ++mt)
#pragma unroll
      for (int r = 0; r < 16; ++r) { float pv = __builtin_amdgcn_exp2f(st[mt][r] - m_new); st[mt][r] = pv; rsum += pv; }
    l_run = l_run * alpha + rsum; m_run = m_new;
#pragma unroll
    for (int d = 0; d < 4; ++d)
#pragma unroll
      for (int r = 0; r < 16; ++r) oacc[d][r] *= alpha;
#pragma unroll
    for (int s = 0; s < 4; ++s) {
      const int mt = s >> 1, ss = s & 1;
      u32x4 pt = {cvtpk(st[mt][8 * ss + 0], st[mt][8 * ss + 1]), cvtpk(st[mt][8 * ss + 2], st[mt][8 * ss + 3]),
                  cvtpk(st[mt][8 * ss + 4], st[mt][8 * ss + 5]), cvtpk(st[mt][8 * ss + 6], st[mt][8 * ss + 7])};
      bf16x8 pf = __builtin_bit_cast(bf16x8, pt);
#pragma unroll
      for (int d = 0; d < 4; ++d) {
        const bf16x8 vf = *(const bf16x8*)(bV + (d * 32 + l31) * 72 + mt * 32 + ss * 16 + hf * 8);
        oacc[d] = mfma32(vf, pf, oacc[d]);
      }
    }
  };
  gload(ak, av, 0); swrite(ak, av, 0); gload(bk, bv, 1);
  lds_barrier();
#pragma unroll 1
  for (int kt = 0; kt < ntiles; kt += 2) {
    if (kt + 2 < ntiles) gload(ak, av, kt + 2);
    compute(kt, 0);
    if (kt + 1 < ntiles) swrite(bk, bv, 1);
    lds_barrier();
    if (kt + 1 < ntiles) {
      if (kt + 3 < ntiles) gload(bk, bv, kt + 3);
      compute(kt + 1, 1);
      if (kt + 2 < ntiles) swrite(ak, av, 0);
      lds_barrier();
    }
  }
  const float l_tot = l_run + __shfl_xor(l_run, 32);
  const float inv = 1.f / l_tot;
#pragma unroll
  for (int d = 0; d < 4; ++d)
#pragma unroll
    for (int g = 0; g < 4; ++g) {
      float4 o4 = make_float4(oacc[d][4 * g] * inv, oacc[d][4 * g + 1] * inv, oacc[d][4 * g + 2] * inv, oacc[d][4 * g + 3] * inv);
      *(float4*)(sO + ((map * 64 + r0 + l31) * 132 + d * 32 + 8 * g + 4 * hf)) = o4;
    }
  __syncthreads();
  {
    const int q = tid >> 2, qq = tid & 3;
    const float4* o0 = (const float4*)(sO + (q * 132 + qq * 32)); const float4* o1 = (const float4*)(sO + ((64 + q) * 132 + qq * 32));
    float ss = 0.f;
#pragma unroll
    for (int i = 0; i < 8; ++i) {
      float4 a = o0[i], c = o1[i];
      float dx = a.x - lam * c.x, dy = a.y - lam * c.y, dz = a.z - lam * c.z, dw = a.w - lam * c.w;
      ss += dx * dx + dy * dy + dz * dz + dw * dw;
    }
    ss += __shfl_xor(ss, 1); ss += __shfl_xor(ss, 2);
    const float rsn = rsqrtf(ss * (1.f / 128.f) + 1e-6f) * 0.8f;
    const float4* nw = (const float4*)(p.attn_norm_w + qq * 32);
    uint4* dst = (uint4*)(AQ + (size_t)(b * LTOK + NMETA + t0 + q) * 1024 + h * 128 + qq * 32);
#pragma unroll
    for (int i = 0; i < 4; ++i) {
      float4 a0 = o0[2 * i], c0 = o1[2 * i], a1 = o0[2 * i + 1], c1 = o1[2 * i + 1];
      float4 w0 = nw[2 * i], w1 = nw[2 * i + 1];
      uint4 o;
      o.x = cvtpk((a0.x - lam * c0.x) * rsn * w0.x, (a0.y - lam * c0.y) * rsn * w0.y);
      o.y = cvtpk((a0.z - lam * c0.z) * rsn * w0.z, (a0.w - lam * c0.w) * rsn * w0.w);
      o.z = cvtpk((a1.x - lam * c1.x) * rsn * w1.x, (a1.y - lam * c1.y) * rsn * w1.y);
      o.w = cvtpk((a1.z - lam * c1.z) * rsn * w1.z, (a1.w - lam * c1.w) * rsn * w1.w);
      dst[i] = o;
    }
  }
  __syncthreads();
}

__device__ __forceinline__ void phase3(const Params& p, unsigned char* smem, unsigned* bar) {
  __shared__ int s_item;
  const int tid = ltid();
  const bool is_scan = (blockIdx.x < 16);
  float* ssave = (float*)(p.ws + OFF_PSQ) + ((size_t)blockIdx.x * 256 + tid) * 64;
  if (is_scan) {
    f32x16 S[4];
#pragma unroll
    for (int d = 0; d < 4; ++d)
#pragma unroll
      for (int r = 0; r < 16; ++r) S[d][r] = 0.f;
    scan_chunked(p, smem, blockIdx.x, S, 0, P2_SPLIT);
#pragma unroll
    for (int d = 0; d < 4; ++d)
#pragma unroll
      for (int r = 0; r < 16; r += 4) *(float4*)(ssave + d * 16 + r) = make_float4(S[d][r], S[d][r + 1], S[d][r + 2], S[d][r + 3]);
  } else {
    phase2(p, smem, P2_SPLIT * 16, NCH * 16, blockIdx.x - 16, gridDim.x - 16);
  }
  grid_barrier(bar, 3);
  if (is_scan) {
    f32x16 S[4];
#pragma unroll
    for (int d = 0; d < 4; ++d)
#pragma unroll
      for (int r = 0; r < 16; r += 4) { float4 v = *(const float4*)(ssave + d * 16 + r); S[d][r] = v.x; S[d][r + 1] = v.y; S[d][r + 2] = v.z; S[d][r + 3] = v.w; }
    scan_chunked(p, smem, blockIdx.x, S, P2_SPLIT, NCH);
  }
  int* cnt = (int*)(p.ws + OFF_CTL);
  const float lam = ((const float*)(p.ws + OFF_CTL))[16];
  const int myq = blockIdx.x & 7;
  for (int qq = 0; qq < 8; ++qq) {
    const int q = (myq + qq) & 7;
    while (true) {
      if (tid == 0) s_item = atomicAdd(&cnt[q], 1);
      __syncthreads();
      const int idx = s_item;
      __syncthreads();
      if (idx >= 256) break;
      attn_item(p, smem, idx & 1, q, 127 - (idx >> 1), lam);
    }
  }
}

__device__ __forceinline__ int tokrow_of(int m) { int b = m >> 13; return b * LTOK + NMETA + (m & 8191); }

__device__ __forceinline__ void phase4(const Params& p, unsigned char* smem) {
  const u16* hn = (const u16*)p.out; const u16* wtin = hn + (size_t)NTOK * DM;
  u16* AQ = (u16*)(p.ws + OFF_AQ); u16* DX = (u16*)(p.ws + OFF_DX);
  u16* SGA = (u16*)(p.ws + OFF_AK); u16* SGD = (u16*)(p.ws + OFF_AVT);
  const int xcd = blockIdx.x & 7, lw = blockIdx.x >> 3, LW = (gridDim.x - xcd + 7) >> 3;
  for (int i = lw;; i += LW) {
    int mt, nt; if (!tile_map(i, xcd, 128, 32, mt, nt)) break;
    const int m0 = mt * 128;
    const int n0 = nt < 8 ? 3072 + nt * 128 : (nt < 16 ? 7168 + (nt - 8) * 128 : 8208 + (nt - 16) * 128);
    f32x16 acc[2][2]; zero_acc(acc);
    gemm_kloop(acc, [&](int m) { return hn + (size_t)tokrow_of(m) * DM; }, [](int k0) { return (size_t)k0; }, wtin, m0, n0, smem);
    if (nt < 8) {
      epilogue_rows(acc, m0, n0, smem, [&](int m, int n, float4 a, float4 b) {
        uint4* ptr = (uint4*)(AQ + (size_t)tokrow_of(m) * 1024 + (n - 3072));
        uint4 o = *ptr;
        a.x = bflo(o.x) * siluf_(a.x); a.y = bfhi(o.x) * siluf_(a.y); a.z = bflo(o.y) * siluf_(a.z); a.w = bfhi(o.y) * siluf_(a.w);
        b.x = bflo(o.z) * siluf_(b.x); b.y = bfhi(o.z) * siluf_(b.y); b.z = bflo(o.w) * siluf_(b.z); b.w = bfhi(o.w) * siluf_(b.w);
        *ptr = pack8(a, b);
      });
    } else if (nt < 16) {
      epilogue_rows(acc, m0, n0, smem, [&](int m, int n, float4 a, float4 b) {
        int col = n - 7168; int h = col >> 7, d = col & 127;
        int bb = m >> 13, t = m & 8191; int bh = bb * 8 + h; int pp = t + 64;
        uint4* ptr = (uint4*)(DX + (((size_t)(bh * NCH + (pp >> 6))) * 3) * 8192 + (pp & 63) * 128 + d);
        uint4 o = *ptr;
        float o0 = bflo(o.x), o1 = bfhi(o.x), o2 = bflo(o.y), o3 = bfhi(o.y), o4 = bflo(o.z), o5 = bfhi(o.z), o6 = bflo(o.w), o7 = bfhi(o.w);
        float sq = o0 * o0 + o1 * o1 + o2 * o2 + o3 * o3 + o4 * o4 + o5 * o5 + o6 * o6 + o7 * o7;
        sq += __shfl_xor(sq, 1); sq += __shfl_xor(sq, 2); sq += __shfl_xor(sq, 4); sq += __shfl_xor(sq, 8);
        float rs = rsqrtf(sq * (1.f / 128.f) + 1e-6f);
        float4 w0 = *(const float4*)(p.dn_norm_w + d), w1 = *(const float4*)(p.dn_norm_w + d + 4);
        a.x = o0 * rs * w0.x * siluf_(a.x); a.y = o1 * rs * w0.y * siluf_(a.y); a.z = o2 * rs * w0.z * siluf_(a.z); a.w = o3 * rs * w0.w * siluf_(a.w);
        b.x = o4 * rs * w1.x * siluf_(b.x); b.y = o5 * rs * w1.y * siluf_(b.y); b.z = o6 * rs * w1.z * siluf_(b.z); b.w = o7 * rs * w1.w * siluf_(b.w);
        *ptr = pack8(a, b);
      });
    } else {
      epilogue_rows(acc, m0, n0, smem, [&](int m, int n, float4 a, float4 b) {
        int col = n - 8208; u16* dst = col < 1024 ? SGA + col : SGD + (col - 1024);
        a.x = sigmoidf_(a.x); a.y = sigmoidf_(a.y); a.z = sigmoidf_(a.z); a.w = sigmoidf_(a.w);
        b.x = sigmoidf_(b.x); b.y = sigmoidf_(b.y); b.z = sigmoidf_(b.z); b.w = sigmoidf_(b.w);
        *(uint4*)(dst + (size_t)m * 1024) = pack8(a, b);
      });
    }
  }
}

__device__ __forceinline__ void phase5(const Params& p, unsigned char* smem) {
  const u16* AQ = (const u16*)(p.ws + OFF_AQ); const u16* DX = (const u16*)(p.ws + OFF_DX);
  const u16* SGA = (const u16*)(p.ws + OFF_AK); const u16* SGD = (const u16*)(p.ws + OFF_AVT);
  const u16* wat = (const u16*)(p.ws + OFF_W3); const u16* wdt = wat + 1024 * 1024;
  u16* MERGED = (u16*)(p.ws + OFF_EXTRA);
  const int xcd = blockIdx.x & 7, lw = blockIdx.x >> 3, LW = (gridDim.x - xcd + 7) >> 3;
  for (int i = lw;; i += LW) {
    int mt, nt; if (!tile_map(i, xcd, 128, 8, mt, nt)) break;
    const int m0 = mt * 128, n0 = nt * 128;
    f32x16 acc[2][2]; zero_acc(acc);
    gemm_kloop(acc, [&](int m) { return AQ + (size_t)tokrow_of(m) * 1024; }, [](int k0) { return (size_t)k0; }, wat, m0, n0, smem);
    epilogue_rows(acc, m0, n0, smem, [&](int m, int n, float4 a, float4 b) {
      uint4 g = *(const uint4*)(SGA + (size_t)m * 1024 + n);
      a.x *= bflo(g.x); a.y *= bfhi(g.x); a.z *= bflo(g.y); a.w *= bfhi(g.y); b.x *= bflo(g.z); b.y *= bfhi(g.z); b.z *= bflo(g.w); b.w *= bfhi(g.w);
      *(uint4*)(MERGED + (size_t)m * 1024 + n) = pack8(a, b);
    });
  }
  for (int i = lw;; i += LW) {
    int mt, nt; if (!tile_map(i, xcd, 128, 8, mt, nt)) break;
    const int m0 = mt * 128, n0 = nt * 128;
    f32x16 acc[2][2]; zero_acc(acc);
    gemm_kloop(acc, [&](int m) {
      int bb = m >> 13, t = m & 8191; int pp = t + 64;
      return DX + (((size_t)((bb * 8) * NCH + (pp >> 6))) * 3) * 8192 + (pp & 63) * 128;
    }, [](int k0) { return (size_t)(k0 >> 7) * ((size_t)NCH * 3 * 8192) + (size_t)(k0 & 127); }, wdt, m0, n0, smem);
    epilogue_rows(acc, m0, n0, smem, [&](int m, int n, float4 a, float4 b) {
      uint4 g = *(const uint4*)(SGD + (size_t)m * 1024 + n);
      uint4* ptr = (uint4*)(MERGED + (size_t)m * 1024 + n);
      uint4 o = *ptr;
      a.x = bflo(o.x) + a.x * bflo(g.x); a.y = bfhi(o.x) + a.y * bfhi(g.x); a.z = bflo(o.y) + a.z * bflo(g.y); a.w = bfhi(o.y) + a.w * bfhi(g.y);
      b.x = bflo(o.z) + b.x * bflo(g.z); b.y = bfhi(o.z) + b.y * bfhi(g.z); b.z = bflo(o.w) + b.z * bflo(g.w); b.w = bfhi(o.w) + b.w * bfhi(g.w);
      *ptr = pack8(a, b);
    });
  }
}

__device__ __forceinline__ void phase6(const Params& p, unsigned char* smem) {
  const u16* MERGED = (const u16*)(p.ws + OFF_EXTRA);
  const u16* wot = (const u16*)(p.ws + OFF_W3) + 2 * 1024 * 1024;
  float* PSUM = (float*)(p.ws + OFF_PSUM);
  const int xcd = blockIdx.x & 7, lw = blockIdx.x >> 3, LW = (gridDim.x - xcd + 7) >> 3;
  for (int i = lw;; i += LW) {
    int mt, nt; if (!tile_map(i, xcd, 128, 8, mt, nt)) break;
    const int m0 = mt * 128, n0 = nt * 128;
    f32x16 acc[2][2]; zero_acc(acc);
    gemm_kloop(acc, [&](int m) { return MERGED + (size_t)m * 1024; }, [](int k0) { return (size_t)k0; }, wot, m0, n0, smem);
    epilogue_rows(acc, m0, n0, smem, [&](int m, int n, float4 a, float4 b) {
      const float4* xp = (const float4*)(p.x + (size_t)m * 1024 + n);
      float4 x0 = xp[0], x1 = xp[1];
      a.x += x0.x; a.y += x0.y; a.z += x0.z; a.w += x0.w; b.x += x1.x; b.y += x1.y; b.z += x1.z; b.w += x1.w;
      float4* op = (float4*)(p.out + (size_t)m * 1024 + n);
      op[0] = a; op[1] = b;
      float sq = a.x * a.x + a.y * a.y + a.z * a.z + a.w * a.w + b.x * b.x + b.y * b.y + b.z * b.z + b.w * b.w;
      sq += __shfl_xor(sq, 1); sq += __shfl_xor(sq, 2); sq += __shfl_xor(sq, 4); sq += __shfl_xor(sq, 8);
      if ((ltid() & 15) == 0) PSUM[(size_t)nt * NX + m] = sq;
    });
  }
}

__device__ __forceinline__ void phase7(const Params& p) {
  const float* PSUM = (const float*)(p.ws + OFF_PSUM);
  const int tid__ = ltid(); const int lane = tid__ & 63, wave = tid__ >> 6;
  for (int it = blockIdx.x; it < NX / 4; it += gridDim.x) {
    int row = it * 4 + wave;
    float tot = 0.f;
#pragma unroll
    for (int j = 0; j < 8; ++j) tot += PSUM[(size_t)j * NX + row];
    float rs = rsqrtf(tot * (1.f / 1024.f) + 1e-6f);
    float4* o = (float4*)(p.out + (size_t)row * 1024);
#pragma unroll
    for (int i = 0; i < 4; ++i) {
      float4 v = o[lane + 64 * i]; float4 w = ((const float4*)p.final_w)[lane + 64 * i];
      v.x *= rs * w.x; v.y *= rs * w.y; v.z *= rs * w.z; v.w *= rs * w.w;
      o[lane + 64 * i] = v;
    }
  }
}

__global__ void __launch_bounds__(256, 2) mega(Params p) {
  extern __shared__ __attribute__((aligned(16))) unsigned char smem[];
  cg::grid_group grid = cg::this_grid();
  unsigned* bar = (unsigned*)(p.ws + OFF_BAR);
  phase0(p, smem); grid.sync();
  phase1(p, smem); grid_barrier(bar, 1);
  phase2(p, smem, 0, P2_SPLIT * 16, blockIdx.x, gridDim.x); grid_barrier(bar, 2);
  phase3(p, smem, bar); grid_barrier(bar, 4);
  phase4(p, smem); grid_barrier(bar, 5);
  phase5(p, smem); grid_barrier(bar, 6);
  phase6(p, smem); grid_barrier(bar, 7);
  phase7(p);
}

extern "C" void kernel_launch(void* const* d_in, const int* in_sizes, int n_in, void* d_out, int out_size, void* d_ws, size_t ws_size, hipStream_t stream) {
  static int grid_blocks = 0;
  if (!grid_blocks) {
    int dev = 0, cus = 0, per_cu = 0;
    hipGetDevice(&dev);
    hipDeviceGetAttribute(&cus, hipDeviceAttributeMultiprocessorCount, dev);
    hipFuncSetAttribute((const void*)mega, hipFuncAttributeMaxDynamicSharedMemorySize, SMEM_BYTES);
    hipOccupancyMaxActiveBlocksPerMultiprocessor(&per_cu, (const void*)mega, 256, SMEM_BYTES);
    if (per_cu < 1) per_cu = 1;
    if (per_cu > 2) per_cu = 2;
    grid_blocks = cus * per_cu;
    if (ws_size < WS_END) fprintf(stderr, "workspace too small: %zu < %zu\n", ws_size, (size_t)WS_END);
  }
  Params p{};
  p.x = (const float*)d_in[0]; p.meta = (const float*)d_in[1]; p.norm_w = (const float*)d_in[2]; p.w_in = (const float*)d_in[3];
  p.lq1 = (const float*)d_in[4]; p.lk1 = (const float*)d_in[5]; p.lq2 = (const float*)d_in[6]; p.lk2 = (const float*)d_in[7];
  p.attn_norm_w = (const float*)d_in[8]; p.conv_w = (const float*)d_in[9]; p.a_log = (const float*)d_in[10]; p.dt_bias = (const float*)d_in[11];
  p.dn_norm_w = (const float*)d_in[12]; p.w_a = (const float*)d_in[13]; p.w_d = (const float*)d_in[14]; p.w_o = (const float*)d_in[15]; p.final_w = (const float*)d_in[16];
  p.out = (float*)d_out; p.ws = (unsigned char*)d_ws;
  hipMemsetAsync((unsigned char*)d_ws + OFF_BAR, 0, 64, stream);
  void* args[] = {&p};
  hipError_t e = hipLaunchCooperativeKernel((const void*)mega, dim3(grid_blocks), dim3(256), args, SMEM_BYTES, stream);
  if (e != hipSuccess) fprintf(stderr, "cooperative launch failed: %s (grid %d)\n", hipGetErrorString(e), grid_blocks);
}
```

```cpp
#include <hip/hip_runtime.h>
#include <hip/hip_cooperative_groups.h>
#include <stdint.h>
#include <stdio.h>
namespace cg = cooperative_groups;

typedef unsigned short u16;
typedef __attribute__((ext_vector_type(8))) short bf16x8;
typedef __attribute__((ext_vector_type(16))) float f32x16;
typedef __attribute__((ext_vector_type(4))) unsigned u32x4;

constexpr int SEQ = 8192, NMETA = 16, LTOK = 8208, DM = 1024, NTOK = 16416, NX = 16384;
constexpr int LPAD = 8256, NCH = 129, INDIM = 10256;
constexpr float QSCALE = 0.125f * 1.44269504088896f;

constexpr size_t OFF_AQ = 0;
constexpr size_t OFF_AK = 33619968;
constexpr size_t OFF_AVT = 67436544;
constexpr size_t OFF_DX = 101253120;
constexpr size_t OFF_HALO = 202702848;
constexpr size_t OFF_EXTRA = 207458304;
constexpr size_t OFF_W3 = 243388416;
constexpr size_t OFF_BETA = 249679872;
constexpr size_t OFF_G = 250208256;
constexpr size_t OFF_PSQ = 250736640;
constexpr size_t OFF_PSUM = 252850176;
constexpr size_t OFF_CTL = 253898752;
constexpr size_t WS_END = 253902848;
constexpr size_t OFF_BAR = OFF_CTL + 2048;
constexpr int SMEM_BYTES = 73728;
constexpr int P2_SPLIT = 0;

struct Params {
  const float* x; const float* meta; const float* norm_w; const float* w_in;
  const float* lq1; const float* lk1; const float* lq2; const float* lk2;
  const float* attn_norm_w; const float* conv_w; const float* a_log; const float* dt_bias;
  const float* dn_norm_w; const float* w_a; const float* w_d; const float* w_o; const float* final_w;
  float* out; unsigned char* ws;
};

typedef __bf16 bf16x2_t __attribute__((ext_vector_type(2)));
typedef float f32x2_t __attribute__((ext_vector_type(2)));
__device__ __forceinline__ unsigned cvtpk(float lo, float hi) { f32x2_t v = {lo, hi}; bf16x2_t b = __builtin_convertvector(v, bf16x2_t); return __builtin_bit_cast(unsigned, b); }
__device__ __forceinline__ u16 f2bf(float f) { return (u16)(cvtpk(f, 0.f) & 0xffffu); }
__device__ __forceinline__ float bf2f(u16 v) { return __uint_as_float(((unsigned)v) << 16); }
__device__ __forceinline__ float bflo(unsigned v) { return __uint_as_float(v << 16); }
__device__ __forceinline__ float bfhi(unsigned v) { return __uint_as_float(v & 0xffff0000u); }
__device__ __forceinline__ float sigmoidf_(float x) { return 1.f / (1.f + __expf(-x)); }
__device__ __forceinline__ float siluf_(float x) { return x / (1.f + __expf(-x)); }
__device__ __forceinline__ f32x16 mfma32(bf16x8 a, bf16x8 b, f32x16 c) { return __builtin_amdgcn_mfma_f32_32x32x16_bf16(a, b, c, 0, 0, 0); }
__device__ __forceinline__ float wave_sum(float v) {
#pragma unroll
  for (int o = 32; o > 0; o >>= 1) v += __shfl_xor(v, o);
  return v;
}

__device__ __forceinline__ int ltid() { int t = threadIdx.x; asm volatile("" : "+v"(t)); return t; }

__device__ __forceinline__ void lds_barrier() { asm volatile("s_waitcnt lgkmcnt(0)\n\ts_barrier" ::: "memory"); }

__device__ __forceinline__ void grid_barrier(unsigned* ctr, const unsigned k) {
  __syncthreads();
  if (threadIdx.x == 0) {
    __hip_atomic_fetch_add(ctr, 1u, __ATOMIC_RELEASE, __HIP_MEMORY_SCOPE_AGENT);
    const unsigned target = k * gridDim.x;
    while (__hip_atomic_load(ctr, __ATOMIC_RELAXED, __HIP_MEMORY_SCOPE_AGENT) < target) __builtin_amdgcn_s_sleep(1);
    __builtin_amdgcn_fence(__ATOMIC_ACQUIRE, "agent");
  }
  __syncthreads();
}

__device__ __forceinline__ bool tile_map(int i, int xcd, int MT, int NT, int& mt, int& nt) {
  int cm = (MT - xcd + 7) >> 3;
  int ag = i / (8 * NT);
  if (ag * 8 >= cm) return false;
  int gs = cm - ag * 8; if (gs > 8) gs = 8;
  int j = i - ag * 8 * NT;
  if (j >= gs * NT) return false;
  int al = j % gs; nt = j / gs;
  mt = xcd + 8 * (8 * ag + al);
  return true;
}

template <class ARowF, class KOffF>
__device__ __forceinline__ void gemm_kloop(f32x16 (&acc)[2][2], ARowF arow, KOffF koff, const u16* __restrict__ Bt, int m0, int n0, unsigned char* smem) {
  const int tid = ltid(), lane = tid & 63, wave = tid >> 6;
  const int wm = wave >> 1, wn = wave & 1;
  const int lr = tid >> 3, lc = tid & 7;
  const int l31 = lane & 31, hf = lane >> 5;
  u16* sA = (u16*)smem; u16* sB = sA + 2 * 128 * 72;
  const u16* pa0 = arow(m0 + lr) + lc * 8; const u16* pa1 = arow(m0 + lr + 32) + lc * 8;
  const u16* pa2 = arow(m0 + lr + 64) + lc * 8; const u16* pa3 = arow(m0 + lr + 96) + lc * 8;
  const u16* pb0 = Bt + (size_t)(n0 + lr) * 1024 + lc * 8;
  u32x4 ra0, ra1, ra2, ra3, rb0, rb1, rb2, rb3;
  {
    const size_t ko = koff(0);
    ra0 = *(const u32x4*)(pa0 + ko); ra1 = *(const u32x4*)(pa1 + ko); ra2 = *(const u32x4*)(pa2 + ko); ra3 = *(const u32x4*)(pa3 + ko);
    rb0 = *(const u32x4*)(pb0); rb1 = *(const u32x4*)(pb0 + 32 * 1024); rb2 = *(const u32x4*)(pb0 + 64 * 1024); rb3 = *(const u32x4*)(pb0 + 96 * 1024);
  }
  u16* wA0 = sA + lr * 72 + lc * 8; u16* wB0 = sB + lr * 72 + lc * 8;
  *(u32x4*)(wA0) = ra0; *(u32x4*)(wA0 + 32 * 72) = ra1; *(u32x4*)(wA0 + 64 * 72) = ra2; *(u32x4*)(wA0 + 96 * 72) = ra3;
  *(u32x4*)(wB0) = rb0; *(u32x4*)(wB0 + 32 * 72) = rb1; *(u32x4*)(wB0 + 64 * 72) = rb2; *(u32x4*)(wB0 + 96 * 72) = rb3;
  lds_barrier();
#pragma unroll 1
  for (int kt = 0; kt < 16; ++kt) {
    const int buf = kt & 1;
    if (kt + 1 < 16) {
      const size_t ko = koff((kt + 1) * 64); const int kb = (kt + 1) * 64;
      ra0 = *(const u32x4*)(pa0 + ko); ra1 = *(const u32x4*)(pa1 + ko); ra2 = *(const u32x4*)(pa2 + ko); ra3 = *(const u32x4*)(pa3 + ko);
      rb0 = *(const u32x4*)(pb0 + kb); rb1 = *(const u32x4*)(pb0 + 32 * 1024 + kb); rb2 = *(const u32x4*)(pb0 + 64 * 1024 + kb); rb3 = *(const u32x4*)(pb0 + 96 * 1024 + kb);
    }
    const u16* cA = sA + buf * 128 * 72 + (wm * 64 + l31) * 72 + hf * 8;
    const u16* cB = sB + buf * 128 * 72 + (wn * 64 + l31) * 72 + hf * 8;
#pragma unroll
    for (int ks = 0; ks < 4; ++ks) {
      bf16x8 a0 = *(const bf16x8*)(cA + ks * 16);
      bf16x8 a1 = *(const bf16x8*)(cA + 32 * 72 + ks * 16);
      bf16x8 b0 = *(const bf16x8*)(cB + ks * 16);
      bf16x8 b1 = *(const bf16x8*)(cB + 32 * 72 + ks * 16);
      acc[0][0] = mfma32(a0, b0, acc[0][0]);
      acc[0][1] = mfma32(a0, b1, acc[0][1]);
      acc[1][0] = mfma32(a1, b0, acc[1][0]);
      acc[1][1] = mfma32(a1, b1, acc[1][1]);
    }
    if (kt + 1 < 16) {
      u16* wA = wA0 + (buf ^ 1) * 128 * 72; u16* wB = wB0 + (buf ^ 1) * 128 * 72;
      *(u32x4*)(wA) = ra0; *(u32x4*)(wA + 32 * 72) = ra1; *(u32x4*)(wA + 64 * 72) = ra2; *(u32x4*)(wA + 96 * 72) = ra3;
      *(u32x4*)(wB) = rb0; *(u32x4*)(wB + 32 * 72) = rb1; *(u32x4*)(wB + 64 * 72) = rb2; *(u32x4*)(wB + 96 * 72) = rb3;
    }
    lds_barrier();
  }
}

__device__ __forceinline__ void stage_acc(f32x16 (&acc)[2][2], float* sC) {
  const int tid__ = ltid(); const int lane = tid__ & 63, wave = tid__ >> 6;
  const int wm = wave >> 1, wn = wave & 1, l31 = lane & 31, hf = lane >> 5;
  float* base = sC + (wm * 64 + 4 * hf) * 132 + wn * 64 + l31;
#pragma unroll
  for (int mi = 0; mi < 2; ++mi)
#pragma unroll
    for (int ni = 0; ni < 2; ++ni)
#pragma unroll
      for (int r = 0; r < 16; ++r) base[(mi * 32 + 8 * (r >> 2) + (r & 3)) * 132 + ni * 32] = acc[mi][ni][r];
  __syncthreads();
}
template <class Epi>
__device__ __forceinline__ void epilogue_rows(f32x16 (&acc)[2][2], int m0, int n0, unsigned char* smem, Epi epi) {
  float* sC = (float*)smem;
  stage_acc(acc, sC);
  const int tid = ltid();
#pragma unroll 2
  for (int it = 0; it < 8; ++it) {
    int idx = tid + 256 * it; int r = idx >> 4, c8 = (idx & 15) * 8;
    float4 a = *(const float4*)(sC + r * 132 + c8), b = *(const float4*)(sC + r * 132 + c8 + 4);
    epi(m0 + r, n0 + c8, a, b);
  }
  __syncthreads();
}
template <class Epi>
__device__ __forceinline__ void epilogue_cols(f32x16 (&acc)[2][2], int m0, int n0, unsigned char* smem, Epi epi) {
  float* sC = (float*)smem;
  stage_acc(acc, sC);
  const int tid = ltid();
#pragma unroll 2
  for (int it = 0; it < 8; ++it) {
    int idx = tid + 256 * it; int n = idx & 127, r8 = (idx >> 7) * 8;
    const float* s = sC + r8 * 132 + n;
    float4 a = make_float4(s[0], s[132], s[264], s[396]), b = make_float4(s[528], s[660], s[792], s[924]);
    epi(m0 + r8, n0 + n, a, b);
  }
  __syncthreads();
}
__device__ __forceinline__ uint4 pack8(float4 a, float4 b) { uint4 o; o.x = cvtpk(a.x, a.y); o.y = cvtpk(a.z, a.w); o.z = cvtpk(b.x, b.y); o.w = cvtpk(b.z, b.w); return o; }

__device__ __forceinline__ void zero_acc(f32x16 (&acc)[2][2]) {
#pragma unroll
  for (int a = 0; a < 2; ++a)
#pragma unroll
    for (int b = 0; b < 2; ++b)
#pragma unroll
      for (int r = 0; r < 16; ++r) acc[a][b][r] = 0.f;
}

__device__ __forceinline__ void phase0(const Params& p, unsigned char* smem) {
  u16* hn = (u16*)p.out; u16* wtin = hn + (size_t)NTOK * DM;
  u16* w3 = (u16*)(p.ws + OFF_W3);
  const int tid = ltid(), lane = tid & 63, wave = tid >> 6;
  constexpr int N_HN = NTOK / 4;
  constexpr int NT_IN = 161;
  constexpr int N_TR = 16 * NT_IN + 3 * 256;
  constexpr int N_MISC = 16;
  for (int it = blockIdx.x; it < N_HN + N_TR + N_MISC; it += gridDim.x) {
    if (it < N_HN) {
      int row = it * 4 + wave; int b = row / LTOK, pos = row - b * LTOK;
      const float* src = pos < NMETA ? p.meta + pos * DM : p.x + ((size_t)b * SEQ + pos - NMETA) * DM;
      float4 v[4]; float ss = 0.f;
#pragma unroll
      for (int i = 0; i < 4; ++i) { v[i] = ((const float4*)src)[lane + 64 * i]; ss += v[i].x * v[i].x + v[i].y * v[i].y + v[i].z * v[i].z + v[i].w * v[i].w; }
      ss = wave_sum(ss);
      float rs = rsqrtf(ss * (1.f / 1024.f) + 1e-6f);
#pragma unroll
      for (int i = 0; i < 4; ++i) {
        float4 w = ((const float4*)p.norm_w)[lane + 64 * i];
        uint2 o; o.x = cvtpk(v[i].x * rs * w.x, v[i].y * rs * w.y); o.y = cvtpk(v[i].z * rs * w.z, v[i].w * rs * w.w);
        ((uint2*)(hn + (size_t)row * DM))[lane + 64 * i] = o;
      }
    } else if (it < N_HN + N_TR) {
      int j = it - N_HN; const float* W; u16* Wt; int N, kt, nt;
      if (j < 16 * NT_IN) { W = p.w_in; Wt = wtin; N = INDIM; kt = j / NT_IN; nt = j - kt * NT_IN; }
      else { j -= 16 * NT_IN; int mtx = j >> 8; j &= 255; W = mtx == 0 ? p.w_a : (mtx == 1 ? p.w_d : p.w_o); Wt = w3 + (size_t)mtx * 1024 * 1024; N = 1024; kt = j >> 4; nt = j & 15; }
      float* tile = (float*)smem;
#pragma unroll
      for (int i = 0; i < 16; ++i) {
        int k = (tid >> 6) + 4 * i; int n = nt * 64 + (tid & 63);
        tile[k * 65 + (tid & 63)] = n < N ? W[(size_t)(kt * 64 + k) * N + n] : 0.f;
      }
      __syncthreads();
      int kk2 = (tid & 31) * 2;
#pragma unroll
      for (int i = 0; i < 8; ++i) {
        int jj = (tid >> 5) + 8 * i; int n = nt * 64 + jj;
        if (n < N) *(unsigned*)(Wt + (size_t)n * 1024 + kt * 64 + kk2) = cvtpk(tile[kk2 * 65 + jj], tile[(kk2 + 1) * 65 + jj]);
      }
      __syncthreads();
    } else {
      int mi = it - N_HN - N_TR;
      unsigned* ak = (unsigned*)(p.ws + OFF_AK); unsigned* avt = (unsigned*)(p.ws + OFF_AVT);
      for (int idx = mi * 256 + tid; idx < 2 * 48 * 512; idx += N_MISC * 256) {
        int b = idx / (48 * 512), r = idx - b * 48 * 512;
        ak[((size_t)b * LPAD + LTOK) * 512 + r] = 0u;
      }
      for (int idx = mi * 256 + tid; idx < 2048 * 24; idx += N_MISC * 256) {
        int row = idx / 24, c = idx - row * 24;
        avt[(size_t)row * (LPAD / 2) + LTOK / 2 + c] = 0u;
      }
      if (mi == 0) {
        int* ctl = (int*)(p.ws + OFF_CTL);
        if (tid < 16) ctl[tid] = 0;
        if (wave == 1) {
          float a = p.lq1[lane] * p.lk1[lane], c = p.lq2[lane] * p.lk2[lane];
          a = wave_sum(a); c = wave_sum(c);
          if (lane == 0) ((float*)ctl)[16] = __expf(a) - __expf(c) + 0.2f;
        }
      }
    }
  }
}

__device__ __forceinline__ void phase1(const Params& p, unsigned char* smem) {
  const u16* hn = (const u16*)p.out; const u16* wtin = hn + (size_t)NTOK * DM;
  u16* AQ = (u16*)(p.ws + OFF_AQ); u16* AK = (u16*)(p.ws + OFF_AK); u16* AVT = (u16*)(p.ws + OFF_AVT);
  u16* DX = (u16*)(p.ws + OFF_DX); u16* HALO = (u16*)(p.ws + OFF_HALO);
  float* BETA = (float*)(p.ws + OFF_BETA); float* GG = (float*)(p.ws + OFF_G);
  const int xcd = blockIdx.x & 7, lw = blockIdx.x >> 3, LW = (gridDim.x - xcd + 7) >> 3;
  for (int i = lw;; i += LW) {
    int mt, nt; if (!tile_map(i, xcd, 129, 49, mt, nt)) break;
    const int m0 = mt * 128;
    const int n0 = nt < 24 ? nt * 128 : (nt < 48 ? 4096 + (nt - 24) * 128 : 8192);
    f32x16 acc[2][2]; zero_acc(acc);
    gemm_kloop(acc, [&](int m) { int mm = m < NTOK ? m : NTOK - 1; return hn + (size_t)mm * DM; }, [](int k0) { return (size_t)k0; }, wtin, m0, n0, smem);
    if (nt < 8) {
      epilogue_rows(acc, m0, n0, smem, [&](int m, int n, float4 a, float4 b) {
        if (m < NTOK) {
          a.x *= QSCALE; a.y *= QSCALE; a.z *= QSCALE; a.w *= QSCALE; b.x *= QSCALE; b.y *= QSCALE; b.z *= QSCALE; b.w *= QSCALE;
          *(uint4*)(AQ + (size_t)m * 1024 + n) = pack8(a, b);
        }
      });
    } else if (nt < 16) {
      epilogue_rows(acc, m0, n0, smem, [&](int m, int n, float4 a, float4 b) {
        if (m < NTOK) { int bb = m / LTOK, pos = m - bb * LTOK; *(uint4*)(AK + ((size_t)bb * LPAD + pos) * 1024 + (n - 1024)) = pack8(a, b); }
      });
    } else if (nt < 24) {
      epilogue_cols(acc, m0, n0, smem, [&](int m, int n, float4 a, float4 b) {
        if (m < NTOK) { int bb = m / LTOK, pos = m - bb * LTOK; *(uint4*)(AVT + ((size_t)(bb * 1024 + (n - 2048))) * LPAD + pos) = pack8(a, b); }
      });
    } else if (nt < 48) {
      epilogue_rows(acc, m0, n0, smem, [&](int m, int n, float4 a, float4 b) {
        if (m < NTOK) {
          int nn = n - 4096; int which = nn >> 10; int h = (nn >> 7) & 7; int d = nn & 127;
          int bb = m / LTOK, pos = m - bb * LTOK; int pp = pos + 48; int c = pp >> 6, rr = pp & 63;
          size_t blk = ((size_t)((bb * 8 + h) * NCH + c)) * 3 + which;
          uint4 o = pack8(a, b);
          *(uint4*)(DX + blk * 8192 + rr * 128 + d) = o;
          if (rr >= 61) *(uint4*)(HALO + blk * 384 + (rr - 61) * 128 + d) = o;
        }
      });
    } else {
      epilogue_rows(acc, m0, n0, smem, [&](int m, int n, float4 a, float4 b) {
        if (m < NTOK && n < 8208) {
          int isg = n >= 8200;
          int bb = m / LTOK, pos = m - bb * LTOK;
          float v[8] = {a.x, a.y, a.z, a.w, b.x, b.y, b.z, b.w};
#pragma unroll
          for (int h = 0; h < 8; ++h) {
            size_t o = (size_t)(bb * 8 + h) * LPAD + pos + 48;
            if (!isg) BETA[o] = sigmoidf_(v[h]);
            else { float z = v[h] + p.dt_bias[h]; float sp = z > 20.f ? z : log1pf(__expf(z)); GG[o] = -__expf(p.a_log[h]) * sp; }
          }
        }
      });
    }
  }
}

template <bool SIGNAL>
__device__ __forceinline__ void phase2(const Params& p, unsigned char* smem, const int lo, const int hi, const int worker, const int nworkers) {
  u16* DX = (u16*)(p.ws + OFF_DX); const u16* HALO = (const u16*)(p.ws + OFF_HALO);
  const float* BETA = (const float*)(p.ws + OFF_BETA); const float* GG = (const float*)(p.ws + OFF_G);
  u16* TA = (u16*)(p.ws + OFF_EXTRA);
  float* sin = (float*)smem;
  u16* sq = (u16*)(smem + 34304);
  u16* sk = sq + 64 * 136;
  u16* svT = sq;
  float* sgc = (float*)(smem + 34304 + 34816);
  float* sbeta = sgc + 64;
  float* sM = (float*)smem;
  const int tid = ltid(), lane = tid & 63, wave = tid >> 6;
  const int l31 = lane & 31, hf = lane >> 5;
  for (int idx2 = lo + worker; idx2 < hi; idx2 += nworkers) {
    const int bh = idx2 & 15, c = idx2 >> 4; const int it = bh * NCH + c; const int h = bh & 7;
    if (wave == 0) {
      const bool pad = (c == 0 && lane < 48);
      float g = pad ? 0.f : GG[(size_t)bh * LPAD + c * 64 + lane];
      float be = pad ? 0.f : BETA[(size_t)bh * LPAD + c * 64 + lane];
#pragma unroll
      for (int o = 1; o < 64; o <<= 1) { float t = __shfl_up(g, o); if (lane >= o) g += t; }
      sgc[lane] = g; sbeta[lane] = be;
    }
    for (int wi = 0; wi < 3; ++wi) {
      const int which = wi == 0 ? 2 : wi - 1;
      u16* X = DX + ((size_t)it * 3 + which) * 8192;
      const u16* H = HALO + ((size_t)(it - 1) * 3 + which) * 384;
      {
        u32x4 ld[5];
#pragma unroll
        for (int i = 0; i < 5; ++i) {
          const int idx = tid + 256 * i; const int rr = idx >> 4, c8 = (idx & 15) * 8; const int r = rr - 3;
          const bool zero = (idx >= 67 * 16) || (c == 0 && r < 48);
          const u16* srcp = (r < 0) ? (H + rr * 128 + c8) : (X + r * 128 + c8);
          u32x4 z = {0u, 0u, 0u, 0u};
          ld[i] = zero ? z : *(const u32x4*)srcp;
        }
#pragma unroll
        for (int i = 0; i < 5; ++i) {
          const int idx = tid + 256 * i; const int rr = idx >> 4, c8 = (idx & 15) * 8;
          if (idx < 67 * 16) {
            float4 a = make_float4(bflo(ld[i].x), bfhi(ld[i].x), bflo(ld[i].y), bfhi(ld[i].y));
            float4 b = make_float4(bflo(ld[i].z), bfhi(ld[i].z), bflo(ld[i].w), bfhi(ld[i].w));
            *(float4*)(sin + rr * 128 + c8) = a; *(float4*)(sin + rr * 128 + c8 + 4) = b;
          }
        }
      }
      __syncthreads();
      const int d0 = 2 * lane; const int ch = which * 1024 + h * 128 + d0;
      float w0[4], w1[4];
#pragma unroll
      for (int j = 0; j < 4; ++j) { w0[j] = p.conv_w[j * 3072 + ch]; w1[j] = p.conv_w[j * 3072 + ch + 1]; }
      for (int rb = 0; rb < 4; ++rb) {
        float y0[4], y1[4];
#pragma unroll
        for (int u = 0; u < 4; ++u) {
          const int r = wave * 16 + rb * 4 + u;
          float a0 = 0.f, a1 = 0.f;
#pragma unroll
          for (int j = 0; j < 4; ++j) { float2 xv = *(const float2*)(sin + (r + j) * 128 + d0); a0 += w0[j] * xv.x; a1 += w1[j] * xv.y; }
          y0[u] = siluf_(a0); y1[u] = siluf_(a1);
        }
        if (which < 2) {
          float ss[4];
#pragma unroll
          for (int u = 0; u < 4; ++u) ss[u] = y0[u] * y0[u] + y1[u] * y1[u];
#pragma unroll
          for (int o = 32; o > 0; o >>= 1) {
#pragma unroll
            for (int u = 0; u < 4; ++u) ss[u] += __shfl_xor(ss[u], o);
          }
#pragma unroll
          for (int u = 0; u < 4; ++u) {
            const int r = wave * 16 + rb * 4 + u;
            const bool pad = (c == 0 && r < 48);
            float sc = rsqrtf(ss[u] + 1e-6f) * (which == 0 ? 0.08838834764831845f : 1.f);
            if (pad) sc = 0.f;
            unsigned pk = cvtpk(y0[u] * sc, y1[u] * sc);
            *(unsigned*)(X + r * 128 + d0) = pk;
            *(unsigned*)((which == 0 ? sq : sk) + r * 136 + d0) = pk;
          }
        } else {
#pragma unroll
          for (int u = 0; u < 4; ++u) {
            const int r = wave * 16 + rb * 4 + u;
            const bool pad = (c == 0 && r < 48);
            float be = pad ? 0.f : sbeta[r];
            svT[d0 * 72 + r] = f2bf(y0[u] * be); svT[(d0 + 1) * 72 + r] = f2bf(y1[u] * be);
          }
        }
      }
      __syncthreads();
      if (which == 2) {
#pragma unroll
        for (int i = 0; i < 4; ++i) { int idx = tid + 256 * i; int e = idx >> 3, c8 = (idx & 7) * 8; *(uint4*)(X + e * 64 + c8) = *(const uint4*)(svT + e * 72 + c8); }
      }
    }
    const int ti = wave >> 1, tj = wave & 1;
    f32x16 kk, qk;
#pragma unroll
    for (int r = 0; r < 16; ++r) { kk[r] = 0.f; qk[r] = 0.f; }
#pragma unroll
    for (int s = 0; s < 8; ++s) {
      bf16x8 bj = *(const bf16x8*)(sk + (32 * tj + l31) * 136 + s * 16 + hf * 8);
      bf16x8 ak = *(const bf16x8*)(sk + (32 * ti + l31) * 136 + s * 16 + hf * 8);
      bf16x8 aq = *(const bf16x8*)(sq + (32 * ti + l31) * 136 + s * 16 + hf * 8);
      kk = mfma32(ak, bj, kk); qk = mfma32(aq, bj, qk);
    }
    __syncthreads();
    u16* Tg = TA + (size_t)it * 8704; u16* Ag = Tg + 4096; float* SCg = (float*)(Tg + 8192);
    {
      const int j = 32 * tj + l31; const float gcj = sgc[j];
#pragma unroll
      for (int r = 0; r < 16; ++r) {
        const int i = 32 * ti + 8 * (r >> 2) + 4 * hf + (r & 3);
        const float gci = sgc[i]; const float bi = sbeta[i];
        const float dec = __expf(gci - gcj);
        sM[i * 68 + j] = (j < i) ? bi * kk[r] * dec : 0.f;
        Ag[i * 64 + j] = f2bf((j <= i) ? qk[r] * dec : 0.f);
      }
    }
    __syncthreads();
    float* sTc = (float*)sq;
    if (wave == 0) {
      float* mycol = sTc + lane * 68;
#pragma unroll 1
      for (int blk = 0; blk < 4; ++blk) {
        const int r0 = blk * 16;
        float acc[16];
#pragma unroll
        for (int r = 0; r < 16; ++r) acc[r] = 0.f;
#pragma unroll 1
        for (int j = 0; j < r0; j += 4) {
          const float4 t4 = *(const float4*)(mycol + j);
#pragma unroll
          for (int r = 0; r < 16; ++r) {
            const float4 m4 = *(const float4*)(sM + (r0 + r) * 68 + j);
            acc[r] += (m4.x * t4.x + m4.y * t4.y) + (m4.z * t4.z + m4.w * t4.w);
          }
        }
        float tt[16];
#pragma unroll
        for (int r = 0; r < 16; ++r) {
          float s = acc[r];
#pragma unroll
          for (int q4 = 0; q4 < r; q4 += 4) {
            const float4 m4 = *(const float4*)(sM + (r0 + r) * 68 + r0 + q4);
            s += m4.x * tt[q4];
            if (q4 + 1 < r) s += m4.y * tt[q4 + 1];
            if (q4 + 2 < r) s += m4.z * tt[q4 + 2];
            if (q4 + 3 < r) s += m4.w * tt[q4 + 3];
          }
          tt[r] = ((r0 + r == lane) ? 1.f : 0.f) - s;
        }
#pragma unroll
        for (int r = 0; r < 16; r += 4) *(float4*)(mycol + r0 + r) = make_float4(tt[r], tt[r + 1], tt[r + 2], tt[r + 3]);
      }
    }
    __syncthreads();
#pragma unroll
    for (int i = 0; i < 2; ++i) {
      int idx = tid + 256 * i; int r = idx >> 3, c8 = (idx & 7) * 8; const float* s = sTc + c8 * 68 + r;
      uint4 o; o.x = cvtpk(s[0], s[68]); o.y = cvtpk(s[136], s[204]); o.z = cvtpk(s[272], s[340]); o.w = cvtpk(s[408], s[476]);
      *(uint4*)(Tg + r * 64 + c8) = o;
    }
    if (tid < 64) {
      float gc = sgc[tid], be = sbeta[tid]; float eg = __expf(gc);
      SCg[tid] = be; SCg[64 + tid] = be * eg; SCg[128 + tid] = eg; SCg[192 + tid] = __expf(sgc[63] - gc);
    }
    __syncthreads();
    if (SIGNAL && tid == 0)
      __hip_atomic_fetch_add((unsigned*)(p.ws + OFF_BAR) + 16 + bh * 17 + (c >> 3), 1u, __ATOMIC_RELEASE, __HIP_MEMORY_SCOPE_AGENT);
  }
}

__device__ __forceinline__ bf16x8 mk8(uint2 lo, uint2 hi) { u32x4 t = {lo.x, lo.y, hi.x, hi.y}; return __builtin_bit_cast(bf16x8, t); }

__device__ __forceinline__ void scan_chunked(const Params& p, unsigned char* smem, int bh, f32x16 (&S)[4], const int c_begin, const int c_end) {
  u16* DX = (u16*)(p.ws + OFF_DX); const u16* TA = (const u16*)(p.ws + OFF_EXTRA);
  const int tid = ltid(), lane = tid & 63, wave = tid >> 6;
  const int l31 = lane & 31, hf = lane >> 5;
  u16* sk = (u16*)smem;
  u16* sq = sk + 64 * 136;
  u16* sT = sq + 64 * 136;
  u16* sA = sT + 64 * 72;
  float* sSC = (float*)(sA + 64 * 72);
  u32x4 pk[4], pq[4], pT[2], pA[2]; uint2 pv[8]; float psc;
#pragma unroll 1
  for (int c = c_begin; c < c_end; ++c) {
    if (c >= P2_SPLIT && (c & 7) == 0) {
      const unsigned need = (c == 128) ? 1u : 8u;
      if (tid == 0) {
        const unsigned* f = (const unsigned*)(p.ws + OFF_BAR) + 16 + bh * 17 + (c >> 3);
        while (__hip_atomic_load(f, __ATOMIC_RELAXED, __HIP_MEMORY_SCOPE_AGENT) < need) __builtin_amdgcn_s_sleep(2);
        __builtin_amdgcn_fence(__ATOMIC_ACQUIRE, "agent");
      }
      __syncthreads();
    }
    {
      const u16* Xq = DX + ((size_t)(bh * NCH + c) * 3) * 8192; const u16* Xk = Xq + 8192; const u16* Xv = Xk + 8192;
      const u16* Tg = TA + (size_t)(bh * NCH + c) * 8704; const u16* Ag = Tg + 4096;
#pragma unroll
      for (int i = 0; i < 4; ++i) { pk[i] = *(const u32x4*)(Xk + (tid + 256 * i) * 8); pq[i] = *(const u32x4*)(Xq + (tid + 256 * i) * 8); }
#pragma unroll
      for (int i = 0; i < 2; ++i) { pT[i] = *(const u32x4*)(Tg + (tid + 256 * i) * 8); pA[i] = *(const u32x4*)(Ag + (tid + 256 * i) * 8); }
      psc = ((const float*)(Tg + 8192))[tid];
#pragma unroll
      for (int i = 0; i < 8; ++i) pv[i] = *(const uint2*)(Xv + (wave * 32 + l31) * 64 + 32 * (i >> 2) + 8 * (i & 3) + 4 * hf);
    }
#pragma unroll
    for (int i = 0; i < 4; ++i) {
      int idx = tid + 256 * i; int row = idx >> 4, ch = idx & 15; const int po = (ch >> 1) * 16 + (ch & 1) * 4;
      u16* dk = sk + row * 136 + po; *(uint2*)dk = make_uint2(pk[i].x, pk[i].y); *(uint2*)(dk + 8) = make_uint2(pk[i].z, pk[i].w);
      u16* dq = sq + row * 136 + po; *(uint2*)dq = make_uint2(pq[i].x, pq[i].y); *(uint2*)(dq + 8) = make_uint2(pq[i].z, pq[i].w);
    }
#pragma unroll
    for (int i = 0; i < 2; ++i) {
      int idx = tid + 256 * i; int row = idx >> 3, ch = idx & 7; const int po = (ch >> 1) * 16 + (ch & 1) * 4;
      u16* dt = sT + row * 72 + po; *(uint2*)dt = make_uint2(pT[i].x, pT[i].y); *(uint2*)(dt + 8) = make_uint2(pT[i].z, pT[i].w);
      u16* da = sA + row * 72 + po; *(uint2*)da = make_uint2(pA[i].x, pA[i].y); *(uint2*)(da + 8) = make_uint2(pA[i].z, pA[i].w);
    }
    sSC[tid] = psc;
    lds_barrier();
    __builtin_amdgcn_sched_barrier(0);
    u32x4 yf[4];
    {
      f32x16 x0, x1;
#pragma unroll
      for (int r = 0; r < 16; ++r) { x0[r] = 0.f; x1[r] = 0.f; }
#pragma unroll
      for (int dt = 0; dt < 4; ++dt)
#pragma unroll
        for (int s = 0; s < 2; ++s) {
          u32x4 sb = {cvtpk(S[dt][8 * s + 0], S[dt][8 * s + 1]), cvtpk(S[dt][8 * s + 2], S[dt][8 * s + 3]), cvtpk(S[dt][8 * s + 4], S[dt][8 * s + 5]), cvtpk(S[dt][8 * s + 6], S[dt][8 * s + 7])};
          const bf16x8 k0f = *(const bf16x8*)(sk + (l31) * 136 + 32 * dt + 16 * s + 8 * hf);
          const bf16x8 k1f = *(const bf16x8*)(sk + (32 + l31) * 136 + 32 * dt + 16 * s + 8 * hf);
          x0 = mfma32(k0f, __builtin_bit_cast(bf16x8, sb), x0);
          x1 = mfma32(k1f, __builtin_bit_cast(bf16x8, sb), x1);
        }
#pragma unroll
      for (int g = 0; g < 4; ++g) {
        {
          float4 bg4 = *(const float4*)(sSC + 64 + 8 * g + 4 * hf);
          uint2 vb = pv[g];
          yf[(g >> 1)][(g & 1) * 2 + 0] = cvtpk(bflo(vb.x) - bg4.x * x0[4 * g + 0], bfhi(vb.x) - bg4.y * x0[4 * g + 1]);
          yf[(g >> 1)][(g & 1) * 2 + 1] = cvtpk(bflo(vb.y) - bg4.z * x0[4 * g + 2], bfhi(vb.y) - bg4.w * x0[4 * g + 3]);
        }
        {
          float4 bg4 = *(const float4*)(sSC + 64 + 32 + 8 * g + 4 * hf);
          uint2 vb = pv[4 + g];
          yf[2 + (g >> 1)][(g & 1) * 2 + 0] = cvtpk(bflo(vb.x) - bg4.x * x1[4 * g + 0], bfhi(vb.x) - bg4.y * x1[4 * g + 1]);
          yf[2 + (g >> 1)][(g & 1) * 2 + 1] = cvtpk(bflo(vb.y) - bg4.z * x1[4 * g + 2], bfhi(vb.y) - bg4.w * x1[4 * g + 3]);
        }
      }
    }
    __builtin_amdgcn_sched_barrier(0);
    u32x4 vnf[4];
    {
      f32x16 v0, v1;
#pragma unroll
      for (int r = 0; r < 16; ++r) { v0[r] = 0.f; v1[r] = 0.f; }
#pragma unroll
      for (int s = 0; s < 4; ++s) {
        const bf16x8 t0f = *(const bf16x8*)(sT + (l31) * 72 + 16 * s + 8 * hf);
        const bf16x8 t1f = *(const bf16x8*)(sT + (32 + l31) * 72 + 16 * s + 8 * hf);
        v0 = mfma32(t0f, __builtin_bit_cast(bf16x8, yf[s]), v0);
        v1 = mfma32(t1f, __builtin_bit_cast(bf16x8, yf[s]), v1);
      }
#pragma unroll
      for (int g = 0; g < 4; ++g) {
        vnf[(g >> 1)][(g & 1) * 2 + 0] = cvtpk(v0[4 * g + 0], v0[4 * g + 1]);
        vnf[(g >> 1)][(g & 1) * 2 + 1] = cvtpk(v0[4 * g + 2], v0[4 * g + 3]);
        vnf[2 + (g >> 1)][(g & 1) * 2 + 0] = cvtpk(v1[4 * g + 0], v1[4 * g + 1]);
        vnf[2 + (g >> 1)][(g & 1) * 2 + 1] = cvtpk(v1[4 * g + 2], v1[4 * g + 3]);
      }
    }
    __builtin_amdgcn_sched_barrier(0);
    u16* Oq = DX + ((size_t)(bh * NCH + c) * 3) * 8192;
    {
      f32x16 o0, o1;
#pragma unroll
      for (int r = 0; r < 16; ++r) { o0[r] = 0.f; o1[r] = 0.f; }
#pragma unroll
      for (int dt = 0; dt < 4; ++dt)
#pragma unroll
        for (int s = 0; s < 2; ++s) {
          u32x4 sb = {cvtpk(S[dt][8 * s + 0], S[dt][8 * s + 1]), cvtpk(S[dt][8 * s + 2], S[dt][8 * s + 3]), cvtpk(S[dt][8 * s + 4], S[dt][8 * s + 5]), cvtpk(S[dt][8 * s + 6], S[dt][8 * s + 7])};
          const bf16x8 q0f = *(const bf16x8*)(sq + (l31) * 136 + 32 * dt + 16 * s + 8 * hf);
          const bf16x8 q1f = *(const bf16x8*)(sq + (32 + l31) * 136 + 32 * dt + 16 * s + 8 * hf);
          o0 = mfma32(q0f, __builtin_bit_cast(bf16x8, sb), o0);
          o1 = mfma32(q1f, __builtin_bit_cast(bf16x8, sb), o1);
        }
#pragma unroll
      for (int g = 0; g < 4; ++g) {
        float4 e0 = *(const float4*)(sSC + 128 + 8 * g + 4 * hf), e1 = *(const float4*)(sSC + 128 + 32 + 8 * g + 4 * hf);
        o0[4 * g + 0] *= e0.x; o0[4 * g + 1] *= e0.y; o0[4 * g + 2] *= e0.z; o0[4 * g + 3] *= e0.w;
        o1[4 * g + 0] *= e1.x; o1[4 * g + 1] *= e1.y; o1[4 * g + 2] *= e1.z; o1[4 * g + 3] *= e1.w;
      }
#pragma unroll
      for (int s = 0; s < 4; ++s) {
        const bf16x8 a0f = *(const bf16x8*)(sA + (l31) * 72 + 16 * s + 8 * hf);
        const bf16x8 a1f = *(const bf16x8*)(sA + (32 + l31) * 72 + 16 * s + 8 * hf);
        o0 = mfma32(a0f, __builtin_bit_cast(bf16x8, vnf[s]), o0);
        o1 = mfma32(a1f, __builtin_bit_cast(bf16x8, vnf[s]), o1);
      }
#pragma unroll
      for (int r = 0; r < 16; ++r) {
        Oq[(8 * (r >> 2) + 4 * hf + (r & 3)) * 128 + wave * 32 + l31] = f2bf(o0[r]);
        Oq[(32 + 8 * (r >> 2) + 4 * hf + (r & 3)) * 128 + wave * 32 + l31] = f2bf(o1[r]);
      }
    }
    __builtin_amdgcn_sched_barrier(0);
    const float cd = sSC[128 + 63];
#pragma unroll
    for (int dt = 0; dt < 4; ++dt)
#pragma unroll
      for (int r = 0; r < 16; ++r) S[dt][r] *= cd;
    u32x4 vs[4];
#pragma unroll
    for (int s = 0; s < 4; ++s) {
      const float4 e0 = *(const float4*)(sSC + 192 + 16 * s + 4 * hf), e1 = *(const float4*)(sSC + 192 + 16 * s + 8 + 4 * hf);
      vs[s].x = cvtpk(bflo(vnf[s].x) * e0.x, bfhi(vnf[s].x) * e0.y); vs[s].y = cvtpk(bflo(vnf[s].y) * e0.z, bfhi(vnf[s].y) * e0.w);
      vs[s].z = cvtpk(bflo(vnf[s].z) * e1.x, bfhi(vnf[s].z) * e1.y); vs[s].w = cvtpk(bflo(vnf[s].w) * e1.z, bfhi(vnf[s].w) * e1.w);
    }
    {
      u32x4 id1 = {0u, 0u, 0u, 0u}, id2 = {0u, 0u, 0u, 0u};
      {
        const int l15 = l31 & 15;
        const int jsel = (((l15 >> 2) & 1) == hf) ? (4 * (l15 >> 3) + (l15 & 3)) : -1;
        const int j1 = (l31 < 16) ? jsel : -1;
        const int j2 = (l31 >= 16) ? jsel : -1;
        const unsigned one_lo = 0x3f80u, one_hi = 0x3f800000u;
#pragma unroll
        for (int w = 0; w < 4; ++w) {
          id1[w] = (j1 == 2 * w) ? one_lo : ((j1 == 2 * w + 1) ? one_hi : 0u);
          id2[w] = (j2 == 2 * w) ? one_lo : ((j2 == 2 * w + 1) ? one_hi : 0u);
        }
      }
      const bf16x8 B1 = __builtin_bit_cast(bf16x8, id1), B2 = __builtin_bit_cast(bf16x8, id2);
#pragma unroll
      for (int dt = 0; dt < 4; ++dt)
#pragma unroll
        for (int mt = 0; mt < 2; ++mt) {
          f32x16 kt;
#pragma unroll
          for (int r = 0; r < 16; ++r) kt[r] = 0.f;
          const u16* k0 = sk + (32 * mt + l31) * 136 + 32 * dt + 8 * hf;
          kt = mfma32(*(const bf16x8*)(k0), B1, kt);
          kt = mfma32(*(const bf16x8*)(k0 + 16), B2, kt);
#pragma unroll
          for (int s2 = 0; s2 < 2; ++s2) {
            u32x4 af = {cvtpk(kt[8 * s2 + 0], kt[8 * s2 + 1]), cvtpk(kt[8 * s2 + 2], kt[8 * s2 + 3]), cvtpk(kt[8 * s2 + 4], kt[8 * s2 + 5]), cvtpk(kt[8 * s2 + 6], kt[8 * s2 + 7])};
            S[dt] = mfma32(__builtin_bit_cast(bf16x8, af), __builtin_bit_cast(bf16x8, vs[2 * mt + s2]), S[dt]);
          }
        }
    }
    lds_barrier();
  }
}

__device__ __forceinline__ void attn_item(const Params& p, unsigned char* smem, int b, int h, int qb, float lam) {
  int tid_ = ltid();
  const int tid = tid_, lane = tid & 63, wave = tid >> 6;
  const int l31 = lane & 31, hf = lane >> 5;
  const int map = wave >> 1, r0 = (wave & 1) * 32;
  u16* AQ = (u16*)(p.ws + OFF_AQ); const u16* AK = (const u16*)(p.ws + OFF_AK); const u16* AVT = (const u16*)(p.ws + OFF_AVT);
  u16* sK = (u16*)smem;
  float* sO = (float*)smem;
  const int t0 = qb * 64; const int ntiles = qb + 2;
  const size_t qrow = (size_t)(b * LTOK + NMETA + t0 + r0 + l31);
  bf16x8 qf[4];
#pragma unroll
  for (int s = 0; s < 4; ++s) qf[s] = *(const bf16x8*)(AQ + qrow * 1024 + h * 128 + map * 64 + s * 16 + hf * 8);
  f32x16 oacc[4];
#pragma unroll
  for (int d = 0; d < 4; ++d)
#pragma unroll
    for (int r = 0; r < 16; ++r) oacc[d][r] = 0.f;
  float m_run = -1e30f, l_run = 0.f;
  const int qpos = NMETA + t0 + r0 + l31;
  const u16* kbase = AK + ((size_t)b * LPAD) * 1024 + h * 128;
  const u16* vbase = AVT + ((size_t)(b * 8 + h) * 128) * LPAD;
  const int kc = tid & 15, kr = tid >> 4;
  const int vc = tid & 7, vr = tid >> 3;
  u32x4 ak[4], av[4], bk[4], bv[4];
  auto gload = [&](u32x4 (&rk)[4], u32x4 (&rv)[4], int kt) {
#pragma unroll
    for (int i = 0; i < 4; ++i) {
      rk[i] = *(const u32x4*)(kbase + (size_t)(kt * 64 + kr + 16 * i) * 1024 + kc * 8);
      rv[i] = *(const u32x4*)(vbase + (size_t)(vr + 32 * i) * LPAD + kt * 64 + vc * 8);
    }
  };
  auto swrite = [&](const u32x4 (&rk)[4], const u32x4 (&rv)[4], int buf) {
    u16* bK = sK + buf * 17920; u16* bV = bK + 64 * 136;
#pragma unroll
    for (int i = 0; i < 4; ++i) {
      *(u32x4*)(bK + (kr + 16 * i) * 136 + kc * 8) = rk[i];
      u16* dst = bV + (vr + 32 * i) * 72 + (vc >> 1) * 16 + (vc & 1) * 4;
      *(uint2*)dst = make_uint2(rv[i].x, rv[i].y); *(uint2*)(dst + 8) = make_uint2(rv[i].z, rv[i].w);
    }
  };
  auto compute = [&](int kt, int buf) {
    const u16* bK = sK + buf * 17920; const u16* bV = bK + 64 * 136;
    f32x16 st[2];
#pragma unroll
    for (int mt = 0; mt < 2; ++mt) {
#pragma unroll
      for (int r = 0; r < 16; ++r) st[mt][r] = 0.f;
#pragma unroll
      for (int s = 0; s < 4; ++s) {
        bf16x8 kf = *(const bf16x8*)(bK + (mt * 32 + l31) * 136 + map * 64 + s * 16 + hf * 8);
        st[mt] = mfma32(kf, qf[s], st[mt]);
      }
    }
    if (kt >= ntiles - 2) {
#pragma unroll
      for (int mt = 0; mt < 2; ++mt)
#pragma unroll
        for (int r = 0; r < 16; ++r) {
          int key = kt * 64 + mt * 32 + 8 * (r >> 2) + 4 * hf + (r & 3);
          if (key > qpos) st[mt][r] = -1e30f;
        }
    }
    float mx = -1e30f;
#pragma unroll
    for (int mt = 0; mt < 2; ++mt)
#pragma unroll
      for (int r = 0; r < 16; ++r) mx = fmaxf(mx, st[mt][r]);
    mx = fmaxf(mx, __shfl_xor(mx, 32));
    const float m_new = fmaxf(m_run, mx);
    const float alpha = __builtin_amdgcn_exp2f(m_run - m_new);
    float rsum = 0.f;
#pragma unroll
    for (int mt = 0; mt < 2; ++mt)
#pragma unroll
      for (int r = 0; r < 16; ++r) { float pv = __builtin_amdgcn_exp2f(st[mt][r] - m_new); st[mt][r] = pv; rsum += pv; }
    l_run = l_run * alpha + rsum; m_run = m_new;
#pragma unroll
    for (int d = 0; d < 4; ++d)
#pragma unroll
      for (int r = 0; r < 16; ++r) oacc[d][r] *= alpha;
#pragma unroll
    for (int s = 0; s < 4; ++s) {
      const int mt = s >> 1, ss = s & 1;
      u32x4 pt = {cvtpk(st[mt][8 * ss + 0], st[mt][8 * ss + 1]), cvtpk(st[mt][8 * ss + 2], st[mt][8 * ss + 3]),
                  cvtpk(st[mt][8 * ss + 4], st[mt][8 * ss + 5]), cvtpk(st[mt][8 * ss + 6], st[mt][8 * ss + 7])};
      bf16x8 pf = __builtin_bit_cast(bf16x8, pt);
#pragma unroll
      for (int d = 0; d < 4; ++d) {
        const bf16x8 vf = *(const bf16x8*)(bV + (d * 32 + l31) * 72 + mt * 32 + ss * 16 + hf * 8);
        oacc[d] = mfma32(vf, pf, oacc[d]);
      }
    }
  };
  gload(ak, av, 0); swrite(ak, av, 0); gload(bk, bv, 1);
  lds_barrier();
#pragma unroll 1
  for (int kt = 0; kt < ntiles; kt += 2) {
    if (kt + 2 < ntiles) gload(ak, av, kt + 2);
    compute(kt, 0);
    if (kt + 1 < ntiles) swrite(bk, bv, 1);
    lds_barrier();
    if (kt + 1 < ntiles) {
      if (kt + 3 < ntiles) gload(bk, bv, kt + 3);
      compute(kt + 1, 1);
      if (kt + 2 < ntiles) swrite(ak, av, 0);
      lds_barrier();
    }
  }
  const float l_tot = l_run + __shfl_xor(l_run, 32);
  const float inv = 1.f / l_tot;
#pragma unroll
  for (int d = 0; d < 4; ++d)
#pragma unroll
    for (int g = 0; g < 4; ++g) {
      float4 o4 = make_float4(oacc[d][4 * g] * inv, oacc[d][4 * g + 1] * inv, oacc[d][4 * g + 2] * inv, oacc[d][4 * g + 3] * inv);
      *(float4*)(sO + ((map * 64 + r0 + l31) * 132 + d * 32 + 8 * g + 4 * hf)) = o4;
    }
  __syncthreads();
  {
    const int q = tid >> 2, qq = tid & 3;
    const float4* o0 = (const float4*)(sO + (q * 132 + qq * 32)); const float4* o1 = (const float4*)(sO + ((64 + q) * 132 + qq * 32));
    float ss = 0.f;
#pragma unroll
    for (int i = 0; i < 8; ++i) {
      float4 a = o0[i], c = o1[i];
      float dx = a.x - lam * c.x, dy = a.y - lam * c.y, dz = a.z - lam * c.z, dw = a.w - lam * c.w;
      ss += dx * dx + dy * dy + dz * dz + dw * dw;
    }
    ss += __shfl_xor(ss, 1); ss += __shfl_xor(ss, 2);
    const float rsn = rsqrtf(ss * (1.f / 128.f) + 1e-6f) * 0.8f;
    const float4* nw = (const float4*)(p.attn_norm_w + qq * 32);
    uint4* dst = (uint4*)(AQ + (size_t)(b * LTOK + NMETA + t0 + q) * 1024 + h * 128 + qq * 32);
#pragma unroll
    for (int i = 0; i < 4; ++i) {
      float4 a0 = o0[2 * i], c0 = o1[2 * i], a1 = o0[2 * i + 1], c1 = o1[2 * i + 1];
      float4 w0 = nw[2 * i], w1 = nw[2 * i + 1];
      uint4 o;
      o.x = cvtpk((a0.x - lam * c0.x) * rsn * w0.x, (a0.y - lam * c0.y) * rsn * w0.y);
      o.y = cvtpk((a0.z - lam * c0.z) * rsn * w0.z, (a0.w - lam * c0.w) * rsn * w0.w);
      o.z = cvtpk((a1.x - lam * c1.x) * rsn * w1.x, (a1.y - lam * c1.y) * rsn * w1.y);
      o.w = cvtpk((a1.z - lam * c1.z) * rsn * w1.z, (a1.w - lam * c1.w) * rsn * w1.w);
      dst[i] = o;
    }
  }
  __syncthreads();
}

__device__ __forceinline__ void phase3(const Params& p, unsigned char* smem, unsigned* bar) {
  __shared__ int s_item;
  const int tid = ltid();
  const bool is_scan = (blockIdx.x < 16);
  if (is_scan) {
    f32x16 S[4];
#pragma unroll
    for (int d = 0; d < 4; ++d)
#pragma unroll
      for (int r = 0; r < 16; ++r) S[d][r] = 0.f;
    scan_chunked(p, smem, blockIdx.x, S, 0, NCH);
  } else {
    phase2<true>(p, smem, P2_SPLIT * 16, NCH * 16, blockIdx.x - 16, gridDim.x - 16);
  }
  int* cnt = (int*)(p.ws + OFF_CTL);
  const float lam = ((const float*)(p.ws + OFF_CTL))[16];
  const int myq = blockIdx.x & 7;
  for (int qq = 0; qq < 8; ++qq) {
    const int q = (myq + qq) & 7;
    while (true) {
      if (tid == 0) s_item = atomicAdd(&cnt[q], 1);
      __syncthreads();
      const int idx = s_item;
      __syncthreads();
      if (idx >= 256) break;
      attn_item(p, smem, idx & 1, q, 127 - (idx >> 1), lam);
    }
  }
}

__device__ __forceinline__ int tokrow_of(int m) { int b = m >> 13; return b * LTOK + NMETA + (m & 8191); }

__device__ __forceinline__ void phase4(const Params& p, unsigned char* smem) {
  const u16* hn = (const u16*)p.out; const u16* wtin = hn + (size_t)NTOK * DM;
  u16* AQ = (u16*)(p.ws + OFF_AQ); u16* DX = (u16*)(p.ws + OFF_DX);
  u16* SGA = (u16*)(p.ws + OFF_AK); u16* SGD = (u16*)(p.ws + OFF_AVT);
  const int xcd = blockIdx.x & 7, lw = blockIdx.x >> 3, LW = (gridDim.x - xcd + 7) >> 3;
  for (int i = lw;; i += LW) {
    int mt, nt; if (!tile_map(i, xcd, 128, 32, mt, nt)) break;
    const int m0 = mt * 128;
    const int n0 = nt < 8 ? 3072 + nt * 128 : (nt < 16 ? 7168 + (nt - 8) * 128 : 8208 + (nt - 16) * 128);
    f32x16 acc[2][2]; zero_acc(acc);
    gemm_kloop(acc, [&](int m) { return hn + (size_t)tokrow_of(m) * DM; }, [](int k0) { return (size_t)k0; }, wtin, m0, n0, smem);
    if (nt < 8) {
      epilogue_rows(acc, m0, n0, smem, [&](int m, int n, float4 a, float4 b) {
        uint4* ptr = (uint4*)(AQ + (size_t)tokrow_of(m) * 1024 + (n - 3072));
        uint4 o = *ptr;
        a.x = bflo(o.x) * siluf_(a.x); a.y = bfhi(o.x) * siluf_(a.y); a.z = bflo(o.y) * siluf_(a.z); a.w = bfhi(o.y) * siluf_(a.w);
        b.x = bflo(o.z) * siluf_(b.x); b.y = bfhi(o.z) * siluf_(b.y); b.z = bflo(o.w) * siluf_(b.z); b.w = bfhi(o.w) * siluf_(b.w);
        *ptr = pack8(a, b);
      });
    } else if (nt < 16) {
      epilogue_rows(acc, m0, n0, smem, [&](int m, int n, float4 a, float4 b) {
        int col = n - 7168; int h = col >> 7, d = col & 127;
        int bb = m >> 13, t = m & 8191; int bh = bb * 8 + h; int pp = t + 64;
        uint4* ptr = (uint4*)(DX + (((size_t)(bh * NCH + (pp >> 6))) * 3) * 8192 + (pp & 63) * 128 + d);
        uint4 o = *ptr;
        float o0 = bflo(o.x), o1 = bfhi(o.x), o2 = bflo(o.y), o3 = bfhi(o.y), o4 = bflo(o.z), o5 = bfhi(o.z), o6 = bflo(o.w), o7 = bfhi(o.w);
        float sq = o0 * o0 + o1 * o1 + o2 * o2 + o3 * o3 + o4 * o4 + o5 * o5 + o6 * o6 + o7 * o7;
        sq += __shfl_xor(sq, 1); sq += __shfl_xor(sq, 2); sq += __shfl_xor(sq, 4); sq += __shfl_xor(sq, 8);
        float rs = rsqrtf(sq * (1.f / 128.f) + 1e-6f);
        float4 w0 = *(const float4*)(p.dn_norm_w + d), w1 = *(const float4*)(p.dn_norm_w + d + 4);
        a.x = o0 * rs * w0.x * siluf_(a.x); a.y = o1 * rs * w0.y * siluf_(a.y); a.z = o2 * rs * w0.z * siluf_(a.z); a.w = o3 * rs * w0.w * siluf_(a.w);
        b.x = o4 * rs * w1.x * siluf_(b.x); b.y = o5 * rs * w1.y * siluf_(b.y); b.z = o6 * rs * w1.z * siluf_(b.z); b.w = o7 * rs * w1.w * siluf_(b.w);
        *ptr = pack8(a, b);
      });
    } else {
      epilogue_rows(acc, m0, n0, smem, [&](int m, int n, float4 a, float4 b) {
        int col = n - 8208; u16* dst = col < 1024 ? SGA + col : SGD + (col - 1024);
        a.x = sigmoidf_(a.x); a.y = sigmoidf_(a.y); a.z = sigmoidf_(a.z); a.w = sigmoidf_(a.w);
        b.x = sigmoidf_(b.x); b.y = sigmoidf_(b.y); b.z = sigmoidf_(b.z); b.w = sigmoidf_(b.w);
        *(uint4*)(dst + (size_t)m * 1024) = pack8(a, b);
      });
    }
  }
}

__device__ __forceinline__ void phase5(const Params& p, unsigned char* smem) {
  const u16* AQ = (const u16*)(p.ws + OFF_AQ); const u16* DX = (const u16*)(p.ws + OFF_DX);
  const u16* SGA = (const u16*)(p.ws + OFF_AK); const u16* SGD = (const u16*)(p.ws + OFF_AVT);
  const u16* wat = (const u16*)(p.ws + OFF_W3); const u16* wdt = wat + 1024 * 1024;
  u16* MERGED = (u16*)(p.ws + OFF_EXTRA);
  const int xcd = blockIdx.x & 7, lw = blockIdx.x >> 3, LW = (gridDim.x - xcd + 7) >> 3;
  for (int i = lw;; i += LW) {
    int mt, nt; if (!tile_map(i, xcd, 128, 8, mt, nt)) break;
    const int m0 = mt * 128, n0 = nt * 128;
    f32x16 acc[2][2]; zero_acc(acc);
    gemm_kloop(acc, [&](int m) { return AQ + (size_t)tokrow_of(m) * 1024; }, [](int k0) { return (size_t)k0; }, wat, m0, n0, smem);
    epilogue_rows(acc, m0, n0, smem, [&](int m, int n, float4 a, float4 b) {
      uint4 g = *(const uint4*)(SGA + (size_t)m * 1024 + n);
      a.x *= bflo(g.x); a.y *= bfhi(g.x); a.z *= bflo(g.y); a.w *= bfhi(g.y); b.x *= bflo(g.z); b.y *= bfhi(g.z); b.z *= bflo(g.w); b.w *= bfhi(g.w);
      *(uint4*)(MERGED + (size_t)m * 1024 + n) = pack8(a, b);
    });
  }
  for (int i = lw;; i += LW) {
    int mt, nt; if (!tile_map(i, xcd, 128, 8, mt, nt)) break;
    const int m0 = mt * 128, n0 = nt * 128;
    f32x16 acc[2][2]; zero_acc(acc);
    gemm_kloop(acc, [&](int m) {
      int bb = m >> 13, t = m & 8191; int pp = t + 64;
      return DX + (((size_t)((bb * 8) * NCH + (pp >> 6))) * 3) * 8192 + (pp & 63) * 128;
    }, [](int k0) { return (size_t)(k0 >> 7) * ((size_t)NCH * 3 * 8192) + (size_t)(k0 & 127); }, wdt, m0, n0, smem);
    epilogue_rows(acc, m0, n0, smem, [&](int m, int n, float4 a, float4 b) {
      uint4 g = *(const uint4*)(SGD + (size_t)m * 1024 + n);
      uint4* ptr = (uint4*)(MERGED + (size_t)m * 1024 + n);
      uint4 o = *ptr;
      a.x = bflo(o.x) + a.x * bflo(g.x); a.y = bfhi(o.x) + a.y * bfhi(g.x); a.z = bflo(o.y) + a.z * bflo(g.y); a.w = bfhi(o.y) + a.w * bfhi(g.y);
      b.x = bflo(o.z) + b.x * bflo(g.z); b.y = bfhi(o.z) + b.y * bfhi(g.z); b.z = bflo(o.w) + b.z * bflo(g.w); b.w = bfhi(o.w) + b.w * bfhi(g.w);
      *ptr = pack8(a, b);
    });
  }
}

__device__ __forceinline__ void phase6(const Params& p, unsigned char* smem) {
  const u16* MERGED = (const u16*)(p.ws + OFF_EXTRA);
  const u16* wot = (const u16*)(p.ws + OFF_W3) + 2 * 1024 * 1024;
  float* PSUM = (float*)(p.ws + OFF_PSUM);
  const int xcd = blockIdx.x & 7, lw = blockIdx.x >> 3, LW = (gridDim.x - xcd + 7) >> 3;
  for (int i = lw;; i += LW) {
    int mt, nt; if (!tile_map(i, xcd, 128, 8, mt, nt)) break;
    const int m0 = mt * 128, n0 = nt * 128;
    f32x16 acc[2][2]; zero_acc(acc);
    gemm_kloop(acc, [&](int m) { return MERGED + (size_t)m * 1024; }, [](int k0) { return (size_t)k0; }, wot, m0, n0, smem);
    epilogue_rows(acc, m0, n0, smem, [&](int m, int n, float4 a, float4 b) {
      const float4* xp = (const float4*)(p.x + (size_t)m * 1024 + n);
      float4 x0 = xp[0], x1 = xp[1];
      a.x += x0.x; a.y += x0.y; a.z += x0.z; a.w += x0.w; b.x += x1.x; b.y += x1.y; b.z += x1.z; b.w += x1.w;
      float4* op = (float4*)(p.out + (size_t)m * 1024 + n);
      op[0] = a; op[1] = b;
      float sq = a.x * a.x + a.y * a.y + a.z * a.z + a.w * a.w + b.x * b.x + b.y * b.y + b.z * b.z + b.w * b.w;
      sq += __shfl_xor(sq, 1); sq += __shfl_xor(sq, 2); sq += __shfl_xor(sq, 4); sq += __shfl_xor(sq, 8);
      if ((ltid() & 15) == 0) PSUM[(size_t)nt * NX + m] = sq;
    });
  }
}

__device__ __forceinline__ void phase7(const Params& p) {
  const float* PSUM = (const float*)(p.ws + OFF_PSUM);
  const int tid__ = ltid(); const int lane = tid__ & 63, wave = tid__ >> 6;
  for (int it = blockIdx.x; it < NX / 4; it += gridDim.x) {
    int row = it * 4 + wave;
    float tot = 0.f;
#pragma unroll
    for (int j = 0; j < 8; ++j) tot += PSUM[(size_t)j * NX + row];
    float rs = rsqrtf(tot * (1.f / 1024.f) + 1e-6f);
    float4* o = (float4*)(p.out + (size_t)row * 1024);
#pragma unroll
    for (int i = 0; i < 4; ++i) {
      float4 v = o[lane + 64 * i]; float4 w = ((const float4*)p.final_w)[lane + 64 * i];
      v.x *= rs * w.x; v.y *= rs * w.y; v.z *= rs * w.z; v.w *= rs * w.w;
      o[lane + 64 * i] = v;
    }
  }
}

__global__ void __launch_bounds__(256, 2) mega(Params p) {
  extern __shared__ __attribute__((aligned(16))) unsigned char smem[];
  cg::grid_group grid = cg::this_grid();
  unsigned* bar = (unsigned*)(p.ws + OFF_BAR);
  phase0(p, smem); grid.sync();
  unsigned bk = 0;
  phase1(p, smem); grid_barrier(bar, ++bk);
  if (P2_SPLIT > 0) { phase2<false>(p, smem, 0, P2_SPLIT * 16, blockIdx.x, gridDim.x); grid_barrier(bar, ++bk); }
  phase3(p, smem, bar); grid_barrier(bar, ++bk);
  phase4(p, smem); grid_barrier(bar, ++bk);
  phase5(p, smem); grid_barrier(bar, ++bk);
  phase6(p, smem); grid_barrier(bar, ++bk);
  phase7(p);
}

extern "C" void kernel_launch(void* const* d_in, const int* in_sizes, int n_in, void* d_out, int out_size, void* d_ws, size_t ws_size, hipStream_t stream) {
  static int grid_blocks = 0;
  if (!grid_blocks) {
    int dev = 0, cus = 0, per_cu = 0;
    hipGetDevice(&dev);
    hipDeviceGetAttribute(&cus, hipDeviceAttributeMultiprocessorCount, dev);
    hipFuncSetAttribute((const void*)mega, hipFuncAttributeMaxDynamicSharedMemorySize, SMEM_BYTES);
    hipOccupancyMaxActiveBlocksPerMultiprocessor(&per_cu, (const void*)mega, 256, SMEM_BYTES);
    if (per_cu < 1) per_cu = 1;
    if (per_cu > 2) per_cu = 2;
    grid_blocks = cus * per_cu;
    if (ws_size < WS_END) fprintf(stderr, "workspace too small: %zu < %zu\n", ws_size, (size_t)WS_END);
  }
  Params p{};
  p.x = (const float*)d_in[0]; p.meta = (const float*)d_in[1]; p.norm_w = (const float*)d_in[2]; p.w_in = (const float*)d_in[3];
  p.lq1 = (const float*)d_in[4]; p.lk1 = (const float*)d_in[5]; p.lq2 = (const float*)d_in[6]; p.lk2 = (const float*)d_in[7];
  p.attn_norm_w = (const float*)d_in[8]; p.conv_w = (const float*)d_in[9]; p.a_log = (const float*)d_in[10]; p.dt_bias = (const float*)d_in[11];
  p.dn_norm_w = (const float*)d_in[12]; p.w_a = (const float*)d_in[13]; p.w_d = (const float*)d_in[14]; p.w_o = (const float*)d_in[15]; p.final_w = (const float*)d_in[16];
  p.out = (float*)d_out; p.ws = (unsigned char*)d_ws;
  hipMemsetAsync((unsigned char*)d_ws + OFF_BAR, 0, 2048, stream);
  void* args[] = {&p};
  hipError_t e = hipLaunchCooperativeKernel((const void*)mega, dim3(grid_blocks), dim3(256), args, SMEM_BYTES, stream);
  if (e != hipSuccess) fprintf(stderr, "cooperative launch failed: %s (grid %d)\n", hipGetErrorString(e), grid_blocks);
}
```

```cpp
#include <hip/hip_runtime.h>
#include <hip/hip_cooperative_groups.h>
#include <stdint.h>
#include <stdio.h>
namespace cg = cooperative_groups;

typedef unsigned short u16;
typedef __attribute__((ext_vector_type(8))) short bf16x8;
typedef __attribute__((ext_vector_type(16))) float f32x16;
typedef __attribute__((ext_vector_type(4))) unsigned u32x4;

constexpr int SEQ = 8192, NMETA = 16, LTOK = 8208, DM = 1024, NTOK = 16416, NX = 16384;
constexpr int LPAD = 8256, NCH = 129, INDIM = 10256;
constexpr float QSCALE = 0.125f * 1.44269504088896f;

constexpr size_t OFF_AQ = 0;
constexpr size_t OFF_AK = 33619968;
constexpr size_t OFF_AVT = 67436544;
constexpr size_t OFF_DX = 101253120;
constexpr size_t OFF_HALO = 202702848;
constexpr size_t OFF_EXTRA = 207458304;
constexpr size_t OFF_W3 = 243388416;
constexpr size_t OFF_BETA = 249679872;
constexpr size_t OFF_G = 250208256;
constexpr size_t OFF_PSQ = 250736640;
constexpr size_t OFF_PSUM = 252850176;
constexpr size_t OFF_CTL = 253898752;
constexpr size_t WS_END = 253902848;
constexpr size_t OFF_BAR = OFF_CTL + 2048;
constexpr int SMEM_BYTES = 73728;
constexpr int P2_SPLIT = 0;

struct Params {
  const float* x; const float* meta; const float* norm_w; const float* w_in;
  const float* lq1; const float* lk1; const float* lq2; const float* lk2;
  const float* attn_norm_w; const float* conv_w; const float* a_log; const float* dt_bias;
  const float* dn_norm_w; const float* w_a; const float* w_d; const float* w_o; const float* final_w;
  float* out; unsigned char* ws;
};

typedef __bf16 bf16x2_t __attribute__((ext_vector_type(2)));
typedef float f32x2_t __attribute__((ext_vector_type(2)));
__device__ __forceinline__ unsigned cvtpk(float lo, float hi) { f32x2_t v = {lo, hi}; bf16x2_t b = __builtin_convertvector(v, bf16x2_t); return __builtin_bit_cast(unsigned, b); }
__device__ __forceinline__ u16 f2bf(float f) { return (u16)(cvtpk(f, 0.f) & 0xffffu); }
__device__ __forceinline__ float bf2f(u16 v) { return __uint_as_float(((unsigned)v) << 16); }
__device__ __forceinline__ float bflo(unsigned v) { return __uint_as_float(v << 16); }
__device__ __forceinline__ float bfhi(unsigned v) { return __uint_as_float(v & 0xffff0000u); }
__device__ __forceinline__ float sigmoidf_(float x) { return 1.f / (1.f + __expf(-x)); }
__device__ __forceinline__ float siluf_(float x) { return x / (1.f + __expf(-x)); }
__device__ __forceinline__ f32x16 mfma32(bf16x8 a, bf16x8 b, f32x16 c) { return __builtin_amdgcn_mfma_f32_32x32x16_bf16(a, b, c, 0, 0, 0); }
__device__ __forceinline__ float wave_sum(float v) {
#pragma unroll
  for (int o = 32; o > 0; o >>= 1) v += __shfl_xor(v, o);
  return v;
}

__device__ __forceinline__ int ltid() { int t = threadIdx.x; asm volatile("" : "+v"(t)); return t; }

__device__ __forceinline__ void lds_barrier() { asm volatile("s_waitcnt lgkmcnt(0)\n\ts_barrier" ::: "memory"); }

__device__ __forceinline__ void grid_barrier(unsigned* ctr, const unsigned k) {
  __syncthreads();
  if (threadIdx.x == 0) {
    __hip_atomic_fetch_add(ctr, 1u, __ATOMIC_RELEASE, __HIP_MEMORY_SCOPE_AGENT);
    const unsigned target = k * gridDim.x;
    while (__hip_atomic_load(ctr, __ATOMIC_RELAXED, __HIP_MEMORY_SCOPE_AGENT) < target) __builtin_amdgcn_s_sleep(1);
    __builtin_amdgcn_fence(__ATOMIC_ACQUIRE, "agent");
  }
  __syncthreads();
}

__device__ __forceinline__ bool tile_map(int i, int xcd, int MT, int NT, int& mt, int& nt) {
  int cm = (MT - xcd + 7) >> 3;
  int ag = i / (8 * NT);
  if (ag * 8 >= cm) return false;
  int gs = cm - ag * 8; if (gs > 8) gs = 8;
  int j = i - ag * 8 * NT;
  if (j >= gs * NT) return false;
  int al = j % gs; nt = j / gs;
  mt = xcd + 8 * (8 * ag + al);
  return true;
}

template <class ARowF, class KOffF>
__device__ __forceinline__ void gemm_kloop(f32x16 (&acc)[2][2], ARowF arow, KOffF koff, const u16* __restrict__ Bt, int m0, int n0, unsigned char* smem) {
  const int tid = ltid(), lane = tid & 63, wave = tid >> 6;
  const int wm = wave >> 1, wn = wave & 1;
  const int lr = tid >> 3, lc = tid & 7;
  const int l31 = lane & 31, hf = lane >> 5;
  u16* sA = (u16*)smem; u16* sB = sA + 2 * 128 * 72;
  const u16* pa0 = arow(m0 + lr) + lc * 8; const u16* pa1 = arow(m0 + lr + 32) + lc * 8;
  const u16* pa2 = arow(m0 + lr + 64) + lc * 8; const u16* pa3 = arow(m0 + lr + 96) + lc * 8;
  const u16* pb0 = Bt + (size_t)(n0 + lr) * 1024 + lc * 8;
  u32x4 ra0, ra1, ra2, ra3, rb0, rb1, rb2, rb3;
  {
    const size_t ko = koff(0);
    ra0 = *(const u32x4*)(pa0 + ko); ra1 = *(const u32x4*)(pa1 + ko); ra2 = *(const u32x4*)(pa2 + ko); ra3 = *(const u32x4*)(pa3 + ko);
    rb0 = *(const u32x4*)(pb0); rb1 = *(const u32x4*)(pb0 + 32 * 1024); rb2 = *(const u32x4*)(pb0 + 64 * 1024); rb3 = *(const u32x4*)(pb0 + 96 * 1024);
  }
  u16* wA0 = sA + lr * 72 + lc * 8; u16* wB0 = sB + lr * 72 + lc * 8;
  *(u32x4*)(wA0) = ra0; *(u32x4*)(wA0 + 32 * 72) = ra1; *(u32x4*)(wA0 + 64 * 72) = ra2; *(u32x4*)(wA0 + 96 * 72) = ra3;
  *(u32x4*)(wB0) = rb0; *(u32x4*)(wB0 + 32 * 72) = rb1; *(u32x4*)(wB0 + 64 * 72) = rb2; *(u32x4*)(wB0 + 96 * 72) = rb3;
  lds_barrier();
#pragma unroll 1
  for (int kt = 0; kt < 16; ++kt) {
    const int buf = kt & 1;
    if (kt + 1 < 16) {
      const size_t ko = koff((kt + 1) * 64); const int kb = (kt + 1) * 64;
      ra0 = *(const u32x4*)(pa0 + ko); ra1 = *(const u32x4*)(pa1 + ko); ra2 = *(const u32x4*)(pa2 + ko); ra3 = *(const u32x4*)(pa3 + ko);
      rb0 = *(const u32x4*)(pb0 + kb); rb1 = *(const u32x4*)(pb0 + 32 * 1024 + kb); rb2 = *(const u32x4*)(pb0 + 64 * 1024 + kb); rb3 = *(const u32x4*)(pb0 + 96 * 1024 + kb);
    }
    const u16* cA = sA + buf * 128 * 72 + (wm * 64 + l31) * 72 + hf * 8;
    const u16* cB = sB + buf * 128 * 72 + (wn * 64 + l31) * 72 + hf * 8;
    __builtin_amdgcn_s_setprio(1);
#pragma unroll
    for (int ks = 0; ks < 4; ++ks) {
      bf16x8 a0 = *(const bf16x8*)(cA + ks * 16);
      bf16x8 a1 = *(const bf16x8*)(cA + 32 * 72 + ks * 16);
      bf16x8 b0 = *(const bf16x8*)(cB + ks * 16);
      bf16x8 b1 = *(const bf16x8*)(cB + 32 * 72 + ks * 16);
      acc[0][0] = mfma32(a0, b0, acc[0][0]);
      acc[0][1] = mfma32(a0, b1, acc[0][1]);
      acc[1][0] = mfma32(a1, b0, acc[1][0]);
      acc[1][1] = mfma32(a1, b1, acc[1][1]);
    }
    __builtin_amdgcn_s_setprio(0);
    if (kt + 1 < 16) {
      u16* wA = wA0 + (buf ^ 1) * 128 * 72; u16* wB = wB0 + (buf ^ 1) * 128 * 72;
      *(u32x4*)(wA) = ra0; *(u32x4*)(wA + 32 * 72) = ra1; *(u32x4*)(wA + 64 * 72) = ra2; *(u32x4*)(wA + 96 * 72) = ra3;
      *(u32x4*)(wB) = rb0; *(u32x4*)(wB + 32 * 72) = rb1; *(u32x4*)(wB + 64 * 72) = rb2; *(u32x4*)(wB + 96 * 72) = rb3;
    }
    lds_barrier();
  }
}

__device__ __forceinline__ void stage_acc(f32x16 (&acc)[2][2], float* sC) {
  const int tid__ = ltid(); const int lane = tid__ & 63, wave = tid__ >> 6;
  const int wm = wave >> 1, wn = wave & 1, l31 = lane & 31, hf = lane >> 5;
  float* base = sC + (wm * 64 + 4 * hf) * 132 + wn * 64 + l31;
#pragma unroll
  for (int mi = 0; mi < 2; ++mi)
#pragma unroll
    for (int ni = 0; ni < 2; ++ni)
#pragma unroll
      for (int r = 0; r < 16; ++r) base[(mi * 32 + 8 * (r >> 2) + (r & 3)) * 132 + ni * 32] = acc[mi][ni][r];
  __syncthreads();
}
template <class Epi>
__device__ __forceinline__ void epilogue_rows(f32x16 (&acc)[2][2], int m0, int n0, unsigned char* smem, Epi epi) {
  float* sC = (float*)smem;
  stage_acc(acc, sC);
  const int tid = ltid();
#pragma unroll 2
  for (int it = 0; it < 8; ++it) {
    int idx = tid + 256 * it; int r = idx >> 4, c8 = (idx & 15) * 8;
    float4 a = *(const float4*)(sC + r * 132 + c8), b = *(const float4*)(sC + r * 132 + c8 + 4);
    epi(m0 + r, n0 + c8, a, b);
  }
  __syncthreads();
}
template <class Epi>
__device__ __forceinline__ void epilogue_cols(f32x16 (&acc)[2][2], int m0, int n0, unsigned char* smem, Epi epi) {
  float* sC = (float*)smem;
  stage_acc(acc, sC);
  const int tid = ltid();
#pragma unroll 2
  for (int it = 0; it < 8; ++it) {
    int idx = tid + 256 * it; int n = idx & 127, r8 = (idx >> 7) * 8;
    const float* s = sC + r8 * 132 + n;
    float4 a = make_float4(s[0], s[132], s[264], s[396]), b = make_float4(s[528], s[660], s[792], s[924]);
    epi(m0 + r8, n0 + n, a, b);
  }
  __syncthreads();
}
__device__ __forceinline__ uint4 pack8(float4 a, float4 b) { uint4 o; o.x = cvtpk(a.x, a.y); o.y = cvtpk(a.z, a.w); o.z = cvtpk(b.x, b.y); o.w = cvtpk(b.z, b.w); return o; }

__device__ __forceinline__ void zero_acc(f32x16 (&acc)[2][2]) {
#pragma unroll
  for (int a = 0; a < 2; ++a)
#pragma unroll
    for (int b = 0; b < 2; ++b)
#pragma unroll
      for (int r = 0; r < 16; ++r) acc[a][b][r] = 0.f;
}

__device__ __forceinline__ void phase0(const Params& p, unsigned char* smem) {
  u16* hn = (u16*)p.out; u16* wtin = hn + (size_t)NTOK * DM;
  u16* w3 = (u16*)(p.ws + OFF_W3);
  const int tid = ltid(), lane = tid & 63, wave = tid >> 6;
  constexpr int N_HN = NTOK / 4;
  constexpr int NT_IN = 161;
  constexpr int N_TR = 16 * NT_IN + 3 * 256;
  constexpr int N_MISC = 16;
  for (int it = blockIdx.x; it < N_HN + N_TR + N_MISC; it += gridDim.x) {
    if (it < N_HN) {
      int row = it * 4 + wave; int b = row / LTOK, pos = row - b * LTOK;
      const float* src = pos < NMETA ? p.meta + pos * DM : p.x + ((size_t)b * SEQ + pos - NMETA) * DM;
      float4 v[4]; float ss = 0.f;
#pragma unroll
      for (int i = 0; i < 4; ++i) { v[i] = ((const float4*)src)[lane + 64 * i]; ss += v[i].x * v[i].x + v[i].y * v[i].y + v[i].z * v[i].z + v[i].w * v[i].w; }
      ss = wave_sum(ss);
      float rs = rsqrtf(ss * (1.f / 1024.f) + 1e-6f);
#pragma unroll
      for (int i = 0; i < 4; ++i) {
        float4 w = ((const float4*)p.norm_w)[lane + 64 * i];
        uint2 o; o.x = cvtpk(v[i].x * rs * w.x, v[i].y * rs * w.y); o.y = cvtpk(v[i].z * rs * w.z, v[i].w * rs * w.w);
        ((uint2*)(hn + (size_t)row * DM))[lane + 64 * i] = o;
      }
    } else if (it < N_HN + N_TR) {
      int j = it - N_HN; const float* W; u16* Wt; int N, kt, nt;
      if (j < 16 * NT_IN) { W = p.w_in; Wt = wtin; N = INDIM; kt = j / NT_IN; nt = j - kt * NT_IN; }
      else { j -= 16 * NT_IN; int mtx = j >> 8; j &= 255; W = mtx == 0 ? p.w_a : (mtx == 1 ? p.w_d : p.w_o); Wt = w3 + (size_t)mtx * 1024 * 1024; N = 1024; kt = j >> 4; nt = j & 15; }
      float* tile = (float*)smem;
#pragma unroll
      for (int i = 0; i < 16; ++i) {
        int k = (tid >> 6) + 4 * i; int n = nt * 64 + (tid & 63);
        tile[k * 65 + (tid & 63)] = n < N ? W[(size_t)(kt * 64 + k) * N + n] : 0.f;
      }
      __syncthreads();
      int kk2 = (tid & 31) * 2;
#pragma unroll
      for (int i = 0; i < 8; ++i) {
        int jj = (tid >> 5) + 8 * i; int n = nt * 64 + jj;
        if (n < N) *(unsigned*)(Wt + (size_t)n * 1024 + kt * 64 + kk2) = cvtpk(tile[kk2 * 65 + jj], tile[(kk2 + 1) * 65 + jj]);
      }
      __syncthreads();
    } else {
      int mi = it - N_HN - N_TR;
      unsigned* ak = (unsigned*)(p.ws + OFF_AK); unsigned* avt = (unsigned*)(p.ws + OFF_AVT);
      for (int idx = mi * 256 + tid; idx < 2 * 48 * 512; idx += N_MISC * 256) {
        int b = idx / (48 * 512), r = idx - b * 48 * 512;
        ak[((size_t)b * LPAD + LTOK) * 512 + r] = 0u;
      }
      for (int idx = mi * 256 + tid; idx < 2048 * 24; idx += N_MISC * 256) {
        int row = idx / 24, c = idx - row * 24;
        avt[(size_t)row * (LPAD / 2) + LTOK / 2 + c] = 0u;
      }
      if (mi == 0) {
        int* ctl = (int*)(p.ws + OFF_CTL);
        if (tid < 16) ctl[tid] = 0;
        if (wave == 1) {
          float a = p.lq1[lane] * p.lk1[lane], c = p.lq2[lane] * p.lk2[lane];
          a = wave_sum(a); c = wave_sum(c);
          if (lane == 0) ((float*)ctl)[16] = __expf(a) - __expf(c) + 0.2f;
        }
      }
    }
  }
}

__device__ __forceinline__ void phase1(const Params& p, unsigned char* smem) {
  const u16* hn = (const u16*)p.out; const u16* wtin = hn + (size_t)NTOK * DM;
  u16* AQ = (u16*)(p.ws + OFF_AQ); u16* AK = (u16*)(p.ws + OFF_AK); u16* AVT = (u16*)(p.ws + OFF_AVT);
  u16* DX = (u16*)(p.ws + OFF_DX); u16* HALO = (u16*)(p.ws + OFF_HALO);
  float* BETA = (float*)(p.ws + OFF_BETA); float* GG = (float*)(p.ws + OFF_G);
  const int xcd = blockIdx.x & 7, lw = blockIdx.x >> 3, LW = (gridDim.x - xcd + 7) >> 3;
  for (int i = lw;; i += LW) {
    int mt, nt; if (!tile_map(i, xcd, 129, 49, mt, nt)) break;
    const int m0 = mt * 128;
    const int n0 = nt < 24 ? nt * 128 : (nt < 48 ? 4096 + (nt - 24) * 128 : 8192);
    f32x16 acc[2][2]; zero_acc(acc);
    gemm_kloop(acc, [&](int m) { int mm = m < NTOK ? m : NTOK - 1; return hn + (size_t)mm * DM; }, [](int k0) { return (size_t)k0; }, wtin, m0, n0, smem);
    if (nt < 8) {
      epilogue_rows(acc, m0, n0, smem, [&](int m, int n, float4 a, float4 b) {
        if (m < NTOK) {
          a.x *= QSCALE; a.y *= QSCALE; a.z *= QSCALE; a.w *= QSCALE; b.x *= QSCALE; b.y *= QSCALE; b.z *= QSCALE; b.w *= QSCALE;
          *(uint4*)(AQ + (size_t)m * 1024 + n) = pack8(a, b);
        }
      });
    } else if (nt < 16) {
      epilogue_rows(acc, m0, n0, smem, [&](int m, int n, float4 a, float4 b) {
        if (m < NTOK) { int bb = m / LTOK, pos = m - bb * LTOK; *(uint4*)(AK + ((size_t)bb * LPAD + pos) * 1024 + (n - 1024)) = pack8(a, b); }
      });
    } else if (nt < 24) {
      epilogue_cols(acc, m0, n0, smem, [&](int m, int n, float4 a, float4 b) {
        if (m < NTOK) { int bb = m / LTOK, pos = m - bb * LTOK; *(uint4*)(AVT + ((size_t)(bb * 1024 + (n - 2048))) * LPAD + pos) = pack8(a, b); }
      });
    } else if (nt < 48) {
      epilogue_rows(acc, m0, n0, smem, [&](int m, int n, float4 a, float4 b) {
        if (m < NTOK) {
          int nn = n - 4096; int which = nn >> 10; int h = (nn >> 7) & 7; int d = nn & 127;
          int bb = m / LTOK, pos = m - bb * LTOK; int pp = pos + 48; int c = pp >> 6, rr = pp & 63;
          size_t blk = ((size_t)((bb * 8 + h) * NCH + c)) * 3 + which;
          uint4 o = pack8(a, b);
          *(uint4*)(DX + blk * 8192 + rr * 128 + d) = o;
          if (rr >= 61) *(uint4*)(HALO + blk * 384 + (rr - 61) * 128 + d) = o;
        }
      });
    } else {
      epilogue_rows(acc, m0, n0, smem, [&](int m, int n, float4 a, float4 b) {
        if (m < NTOK && n < 8208) {
          int isg = n >= 8200;
          int bb = m / LTOK, pos = m - bb * LTOK;
          float v[8] = {a.x, a.y, a.z, a.w, b.x, b.y, b.z, b.w};
#pragma unroll
          for (int h = 0; h < 8; ++h) {
            size_t o = (size_t)(bb * 8 + h) * LPAD + pos + 48;
            if (!isg) BETA[o] = sigmoidf_(v[h]);
            else { float z = v[h] + p.dt_bias[h]; float sp = z > 20.f ? z : log1pf(__expf(z)); GG[o] = -__expf(p.a_log[h]) * sp; }
          }
        }
      });
    }
  }
}

template <bool SIGNAL>
__device__ __forceinline__ void phase2(const Params& p, unsigned char* smem, const int lo, const int hi, const int worker, const int nworkers) {
  u16* DX = (u16*)(p.ws + OFF_DX); const u16* HALO = (const u16*)(p.ws + OFF_HALO);
  const float* BETA = (const float*)(p.ws + OFF_BETA); const float* GG = (const float*)(p.ws + OFF_G);
  u16* TA = (u16*)(p.ws + OFF_EXTRA);
  float* sin = (float*)smem;
  u16* sq = (u16*)(smem + 34304);
  u16* sk = sq + 64 * 136;
  u16* svT = sq;
  float* sgc = (float*)(smem + 34304 + 34816);
  float* sbeta = sgc + 64;
  float* sM = (float*)smem;
  const int tid = ltid(), lane = tid & 63, wave = tid >> 6;
  const int l31 = lane & 31, hf = lane >> 5;
  for (int idx2 = lo + worker; idx2 < hi; idx2 += nworkers) {
    const int bh = idx2 & 15, c = idx2 >> 4; const int it = bh * NCH + c; const int h = bh & 7;
    if (wave == 0) {
      const bool pad = (c == 0 && lane < 48);
      float g = pad ? 0.f : GG[(size_t)bh * LPAD + c * 64 + lane];
      float be = pad ? 0.f : BETA[(size_t)bh * LPAD + c * 64 + lane];
#pragma unroll
      for (int o = 1; o < 64; o <<= 1) { float t = __shfl_up(g, o); if (lane >= o) g += t; }
      sgc[lane] = g; sbeta[lane] = be;
    }
    for (int wi = 0; wi < 3; ++wi) {
      const int which = wi == 0 ? 2 : wi - 1;
      u16* X = DX + ((size_t)it * 3 + which) * 8192;
      const u16* H = HALO + ((size_t)(it - 1) * 3 + which) * 384;
      {
        u32x4 ld[5];
#pragma unroll
        for (int i = 0; i < 5; ++i) {
          const int idx = tid + 256 * i; const int rr = idx >> 4, c8 = (idx & 15) * 8; const int r = rr - 3;
          const bool zero = (idx >= 67 * 16) || (c == 0 && r < 48);
          const u16* srcp = (r < 0) ? (H + rr * 128 + c8) : (X + r * 128 + c8);
          u32x4 z = {0u, 0u, 0u, 0u};
          ld[i] = zero ? z : *(const u32x4*)srcp;
        }
#pragma unroll
        for (int i = 0; i < 5; ++i) {
          const int idx = tid + 256 * i; const int rr = idx >> 4, c8 = (idx & 15) * 8;
          if (idx < 67 * 16) {
            float4 a = make_float4(bflo(ld[i].x), bfhi(ld[i].x), bflo(ld[i].y), bfhi(ld[i].y));
            float4 b = make_float4(bflo(ld[i].z), bfhi(ld[i].z), bflo(ld[i].w), bfhi(ld[i].w));
            *(float4*)(sin + rr * 128 + c8) = a; *(float4*)(sin + rr * 128 + c8 + 4) = b;
          }
        }
      }
      __syncthreads();
      const int d0 = 2 * lane; const int ch = which * 1024 + h * 128 + d0;
      float w0[4], w1[4];
#pragma unroll
      for (int j = 0; j < 4; ++j) { w0[j] = p.conv_w[j * 3072 + ch]; w1[j] = p.conv_w[j * 3072 + ch + 1]; }
      for (int rb = 0; rb < 4; ++rb) {
        float y0[4], y1[4];
#pragma unroll
        for (int u = 0; u < 4; ++u) {
          const int r = wave * 16 + rb * 4 + u;
          float a0 = 0.f, a1 = 0.f;
#pragma unroll
          for (int j = 0; j < 4; ++j) { float2 xv = *(const float2*)(sin + (r + j) * 128 + d0); a0 += w0[j] * xv.x; a1 += w1[j] * xv.y; }
          y0[u] = siluf_(a0); y1[u] = siluf_(a1);
        }
        if (which < 2) {
          float ss[4];
#pragma unroll
          for (int u = 0; u < 4; ++u) ss[u] = y0[u] * y0[u] + y1[u] * y1[u];
#pragma unroll
          for (int o = 32; o > 0; o >>= 1) {
#pragma unroll
            for (int u = 0; u < 4; ++u) ss[u] += __shfl_xor(ss[u], o);
          }
#pragma unroll
          for (int u = 0; u < 4; ++u) {
            const int r = wave * 16 + rb * 4 + u;
            const bool pad = (c == 0 && r < 48);
            float sc = rsqrtf(ss[u] + 1e-6f) * (which == 0 ? 0.08838834764831845f : 1.f);
            if (pad) sc = 0.f;
            unsigned pk = cvtpk(y0[u] * sc, y1[u] * sc);
            *(unsigned*)(X + r * 128 + d0) = pk;
            *(unsigned*)((which == 0 ? sq : sk) + r * 136 + d0) = pk;
          }
        } else {
#pragma unroll
          for (int u = 0; u < 4; ++u) {
            const int r = wave * 16 + rb * 4 + u;
            const bool pad = (c == 0 && r < 48);
            float be = pad ? 0.f : sbeta[r];
            svT[d0 * 72 + r] = f2bf(y0[u] * be); svT[(d0 + 1) * 72 + r] = f2bf(y1[u] * be);
          }
        }
      }
      __syncthreads();
      if (which == 2) {
#pragma unroll
        for (int i = 0; i < 4; ++i) { int idx = tid + 256 * i; int e = idx >> 3, c8 = (idx & 7) * 8; *(uint4*)(X + e * 64 + c8) = *(const uint4*)(svT + e * 72 + c8); }
      }
    }
    const int ti = wave >> 1, tj = wave & 1;
    f32x16 kk, qk;
#pragma unroll
    for (int r = 0; r < 16; ++r) { kk[r] = 0.f; qk[r] = 0.f; }
#pragma unroll
    for (int s = 0; s < 8; ++s) {
      bf16x8 bj = *(const bf16x8*)(sk + (32 * tj + l31) * 136 + s * 16 + hf * 8);
      bf16x8 ak = *(const bf16x8*)(sk + (32 * ti + l31) * 136 + s * 16 + hf * 8);
      bf16x8 aq = *(const bf16x8*)(sq + (32 * ti + l31) * 136 + s * 16 + hf * 8);
      kk = mfma32(ak, bj, kk); qk = mfma32(aq, bj, qk);
    }
    __syncthreads();
    u16* Tg = TA + (size_t)it * 8704; u16* Ag = Tg + 4096; float* SCg = (float*)(Tg + 8192);
    {
      const int j = 32 * tj + l31; const float gcj = sgc[j];
#pragma unroll
      for (int r = 0; r < 16; ++r) {
        const int i = 32 * ti + 8 * (r >> 2) + 4 * hf + (r & 3);
        const float gci = sgc[i]; const float bi = sbeta[i];
        const float dec = __expf(gci - gcj);
        sM[i * 68 + j] = (j < i) ? bi * kk[r] * dec : 0.f;
        Ag[i * 64 + j] = f2bf((j <= i) ? qk[r] * dec : 0.f);
      }
    }
    __syncthreads();
    float* sTc = (float*)sq;
    if (wave == 0) {
      float* mycol = sTc + lane * 68;
#pragma unroll 1
      for (int blk = 0; blk < 4; ++blk) {
        const int r0 = blk * 16;
        float acc[16];
#pragma unroll
        for (int r = 0; r < 16; ++r) acc[r] = 0.f;
#pragma unroll 1
        for (int j = 0; j < r0; j += 4) {
          const float4 t4 = *(const float4*)(mycol + j);
#pragma unroll
          for (int r = 0; r < 16; ++r) {
            const float4 m4 = *(const float4*)(sM + (r0 + r) * 68 + j);
            acc[r] += (m4.x * t4.x + m4.y * t4.y) + (m4.z * t4.z + m4.w * t4.w);
          }
        }
        float tt[16];
#pragma unroll
        for (int r = 0; r < 16; ++r) {
          float s = acc[r];
#pragma unroll
          for (int q4 = 0; q4 < r; q4 += 4) {
            const float4 m4 = *(const float4*)(sM + (r0 + r) * 68 + r0 + q4);
            s += m4.x * tt[q4];
            if (q4 + 1 < r) s += m4.y * tt[q4 + 1];
            if (q4 + 2 < r) s += m4.z * tt[q4 + 2];
            if (q4 + 3 < r) s += m4.w * tt[q4 + 3];
          }
          tt[r] = ((r0 + r == lane) ? 1.f : 0.f) - s;
        }
#pragma unroll
        for (int r = 0; r < 16; r += 4) *(float4*)(mycol + r0 + r) = make_float4(tt[r], tt[r + 1], tt[r + 2], tt[r + 3]);
      }
    }
    __syncthreads();
#pragma unroll
    for (int i = 0; i < 2; ++i) {
      int idx = tid + 256 * i; int r = idx >> 3, c8 = (idx & 7) * 8; const float* s = sTc + c8 * 68 + r;
      uint4 o; o.x = cvtpk(s[0], s[68]); o.y = cvtpk(s[136], s[204]); o.z = cvtpk(s[272], s[340]); o.w = cvtpk(s[408], s[476]);
      *(uint4*)(Tg + r * 64 + c8) = o;
    }
    if (tid < 64) {
      float gc = sgc[tid], be = sbeta[tid]; float eg = __expf(gc);
      SCg[tid] = be; SCg[64 + tid] = be * eg; SCg[128 + tid] = eg; SCg[192 + tid] = __expf(sgc[63] - gc);
    }
    __syncthreads();
    if (SIGNAL && tid == 0)
      __hip_atomic_fetch_add((unsigned*)(p.ws + OFF_BAR) + 16 + bh * 17 + (c >> 3), 1u, __ATOMIC_RELEASE, __HIP_MEMORY_SCOPE_AGENT);
  }
}

__device__ __forceinline__ bf16x8 mk8(uint2 lo, uint2 hi) { u32x4 t = {lo.x, lo.y, hi.x, hi.y}; return __builtin_bit_cast(bf16x8, t); }

__device__ __forceinline__ void scan_chunked(const Params& p, unsigned char* smem, int bh, f32x16 (&S)[4], const int c_begin, const int c_end) {
  u16* DX = (u16*)(p.ws + OFF_DX); const u16* TA = (const u16*)(p.ws + OFF_EXTRA);
  const int tid = ltid(), lane = tid & 63, wave = tid >> 6;
  const int l31 = lane & 31, hf = lane >> 5;
  u16* sk = (u16*)smem;
  u16* sq = sk + 64 * 136;
  u16* sT = sq + 64 * 136;
  u16* sA = sT + 64 * 72;
  float* sSC = (float*)(sA + 64 * 72);
  u32x4 pk[4], pq[4], pT[2], pA[2]; uint2 pv[8]; float psc;
#pragma unroll 1
  for (int c = c_begin; c < c_end; ++c) {
    if (c >= P2_SPLIT && (c & 7) == 0) {
      const unsigned need = (c == 128) ? 1u : 8u;
      if (tid == 0) {
        const unsigned* f = (const unsigned*)(p.ws + OFF_BAR) + 16 + bh * 17 + (c >> 3);
        while (__hip_atomic_load(f, __ATOMIC_RELAXED, __HIP_MEMORY_SCOPE_AGENT) < need) __builtin_amdgcn_s_sleep(2);
        __builtin_amdgcn_fence(__ATOMIC_ACQUIRE, "agent");
      }
      __syncthreads();
    }
    {
      const u16* Xq = DX + ((size_t)(bh * NCH + c) * 3) * 8192; const u16* Xk = Xq + 8192; const u16* Xv = Xk + 8192;
      const u16* Tg = TA + (size_t)(bh * NCH + c) * 8704; const u16* Ag = Tg + 4096;
#pragma unroll
      for (int i = 0; i < 4; ++i) { pk[i] = *(const u32x4*)(Xk + (tid + 256 * i) * 8); pq[i] = *(const u32x4*)(Xq + (tid + 256 * i) * 8); }
#pragma unroll
      for (int i = 0; i < 2; ++i) { pT[i] = *(const u32x4*)(Tg + (tid + 256 * i) * 8); pA[i] = *(const u32x4*)(Ag + (tid + 256 * i) * 8); }
      psc = ((const float*)(Tg + 8192))[tid];
#pragma unroll
      for (int i = 0; i < 8; ++i) pv[i] = *(const uint2*)(Xv + (wave * 32 + l31) * 64 + 32 * (i >> 2) + 8 * (i & 3) + 4 * hf);
    }
#pragma unroll
    for (int i = 0; i < 4; ++i) {
      int idx = tid + 256 * i; int row = idx >> 4, ch = idx & 15; const int po = (ch >> 1) * 16 + (ch & 1) * 4;
      u16* dk = sk + row * 136 + po; *(uint2*)dk = make_uint2(pk[i].x, pk[i].y); *(uint2*)(dk + 8) = make_uint2(pk[i].z, pk[i].w);
      u16* dq = sq + row * 136 + po; *(uint2*)dq = make_uint2(pq[i].x, pq[i].y); *(uint2*)(dq + 8) = make_uint2(pq[i].z, pq[i].w);
    }
#pragma unroll
    for (int i = 0; i < 2; ++i) {
      int idx = tid + 256 * i; int row = idx >> 3, ch = idx & 7; const int po = (ch >> 1) * 16 + (ch & 1) * 4;
      u16* dt = sT + row * 72 + po; *(uint2*)dt = make_uint2(pT[i].x, pT[i].y); *(uint2*)(dt + 8) = make_uint2(pT[i].z, pT[i].w);
      u16* da = sA + row * 72 + po; *(uint2*)da = make_uint2(pA[i].x, pA[i].y); *(uint2*)(da + 8) = make_uint2(pA[i].z, pA[i].w);
    }
    sSC[tid] = psc;
    lds_barrier();
    __builtin_amdgcn_sched_barrier(0);
    u32x4 yf[4];
    {
      f32x16 x0, x1;
#pragma unroll
      for (int r = 0; r < 16; ++r) { x0[r] = 0.f; x1[r] = 0.f; }
#pragma unroll
      for (int dt = 0; dt < 4; ++dt)
#pragma unroll
        for (int s = 0; s < 2; ++s) {
          u32x4 sb = {cvtpk(S[dt][8 * s + 0], S[dt][8 * s + 1]), cvtpk(S[dt][8 * s + 2], S[dt][8 * s + 3]), cvtpk(S[dt][8 * s + 4], S[dt][8 * s + 5]), cvtpk(S[dt][8 * s + 6], S[dt][8 * s + 7])};
          const bf16x8 k0f = *(const bf16x8*)(sk + (l31) * 136 + 32 * dt + 16 * s + 8 * hf);
          const bf16x8 k1f = *(const bf16x8*)(sk + (32 + l31) * 136 + 32 * dt + 16 * s + 8 * hf);
          x0 = mfma32(k0f, __builtin_bit_cast(bf16x8, sb), x0);
          x1 = mfma32(k1f, __builtin_bit_cast(bf16x8, sb), x1);
        }
#pragma unroll
      for (int g = 0; g < 4; ++g) {
        {
          float4 bg4 = *(const float4*)(sSC + 64 + 8 * g + 4 * hf);
          uint2 vb = pv[g];
          yf[(g >> 1)][(g & 1) * 2 + 0] = cvtpk(bflo(vb.x) - bg4.x * x0[4 * g + 0], bfhi(vb.x) - bg4.y * x0[4 * g + 1]);
          yf[(g >> 1)][(g & 1) * 2 + 1] = cvtpk(bflo(vb.y) - bg4.z * x0[4 * g + 2], bfhi(vb.y) - bg4.w * x0[4 * g + 3]);
        }
        {
          float4 bg4 = *(const float4*)(sSC + 64 + 32 + 8 * g + 4 * hf);
          uint2 vb = pv[4 + g];
          yf[2 + (g >> 1)][(g & 1) * 2 + 0] = cvtpk(bflo(vb.x) - bg4.x * x1[4 * g + 0], bfhi(vb.x) - bg4.y * x1[4 * g + 1]);
          yf[2 + (g >> 1)][(g & 1) * 2 + 1] = cvtpk(bflo(vb.y) - bg4.z * x1[4 * g + 2], bfhi(vb.y) - bg4.w * x1[4 * g + 3]);
        }
      }
    }
    __builtin_amdgcn_sched_barrier(0);
    u32x4 vnf[4];
    {
      f32x16 v0, v1;
#pragma unroll
      for (int r = 0; r < 16; ++r) { v0[r] = 0.f; v1[r] = 0.f; }
#pragma unroll
      for (int s = 0; s < 4; ++s) {
        const bf16x8 t0f = *(const bf16x8*)(sT + (l31) * 72 + 16 * s + 8 * hf);
        const bf16x8 t1f = *(const bf16x8*)(sT + (32 + l31) * 72 + 16 * s + 8 * hf);
        v0 = mfma32(t0f, __builtin_bit_cast(bf16x8, yf[s]), v0);
        v1 = mfma32(t1f, __builtin_bit_cast(bf16x8, yf[s]), v1);
      }
#pragma unroll
      for (int g = 0; g < 4; ++g) {
        vnf[(g >> 1)][(g & 1) * 2 + 0] = cvtpk(v0[4 * g + 0], v0[4 * g + 1]);
        vnf[(g >> 1)][(g & 1) * 2 + 1] = cvtpk(v0[4 * g + 2], v0[4 * g + 3]);
        vnf[2 + (g >> 1)][(g & 1) * 2 + 0] = cvtpk(v1[4 * g + 0], v1[4 * g + 1]);
        vnf[2 + (g >> 1)][(g & 1) * 2 + 1] = cvtpk(v1[4 * g + 2], v1[4 * g + 3]);
      }
    }
    __builtin_amdgcn_sched_barrier(0);
    u16* Oq = DX + ((size_t)(bh * NCH + c) * 3) * 8192;
    {
      f32x16 o0, o1;
#pragma unroll
      for (int r = 0; r < 16; ++r) { o0[r] = 0.f; o1[r] = 0.f; }
#pragma unroll
      for (int dt = 0; dt < 4; ++dt)
#pragma unroll
        for (int s = 0; s < 2; ++s) {
          u32x4 sb = {cvtpk(S[dt][8 * s + 0], S[dt][8 * s + 1]), cvtpk(S[dt][8 * s + 2], S[dt][8 * s + 3]), cvtpk(S[dt][8 * s + 4], S[dt][8 * s + 5]), cvtpk(S[dt][8 * s + 6], S[dt][8 * s + 7])};
          const bf16x8 q0f = *(const bf16x8*)(sq + (l31) * 136 + 32 * dt + 16 * s + 8 * hf);
          const bf16x8 q1f = *(const bf16x8*)(sq + (32 + l31) * 136 + 32 * dt + 16 * s + 8 * hf);
          o0 = mfma32(q0f, __builtin_bit_cast(bf16x8, sb), o0);
          o1 = mfma32(q1f, __builtin_bit_cast(bf16x8, sb), o1);
        }
#pragma unroll
      for (int g = 0; g < 4; ++g) {
        float4 e0 = *(const float4*)(sSC + 128 + 8 * g + 4 * hf), e1 = *(const float4*)(sSC + 128 + 32 + 8 * g + 4 * hf);
        o0[4 * g + 0] *= e0.x; o0[4 * g + 1] *= e0.y; o0[4 * g + 2] *= e0.z; o0[4 * g + 3] *= e0.w;
        o1[4 * g + 0] *= e1.x; o1[4 * g + 1] *= e1.y; o1[4 * g + 2] *= e1.z; o1[4 * g + 3] *= e1.w;
      }
#pragma unroll
      for (int s = 0; s < 4; ++s) {
        const bf16x8 a0f = *(const bf16x8*)(sA + (l31) * 72 + 16 * s + 8 * hf);
        const bf16x8 a1f = *(const bf16x8*)(sA + (32 + l31) * 72 + 16 * s + 8 * hf);
        o0 = mfma32(a0f, __builtin_bit_cast(bf16x8, vnf[s]), o0);
        o1 = mfma32(a1f, __builtin_bit_cast(bf16x8, vnf[s]), o1);
      }
#pragma unroll
      for (int r = 0; r < 16; ++r) {
        Oq[(8 * (r >> 2) + 4 * hf + (r & 3)) * 128 + wave * 32 + l31] = f2bf(o0[r]);
        Oq[(32 + 8 * (r >> 2) + 4 * hf + (r & 3)) * 128 + wave * 32 + l31] = f2bf(o1[r]);
      }
    }
    __builtin_amdgcn_sched_barrier(0);
    const float cd = sSC[128 + 63];
#pragma unroll
    for (int dt = 0; dt < 4; ++dt)
#pragma unroll
      for (int r = 0; r < 16; ++r) S[dt][r] *= cd;
    u32x4 vs[4];
#pragma unroll
    for (int s = 0; s < 4; ++s) {
      const float4 e0 = *(const float4*)(sSC + 192 + 16 * s + 4 * hf), e1 = *(const float4*)(sSC + 192 + 16 * s + 8 + 4 * hf);
      vs[s].x = cvtpk(bflo(vnf[s].x) * e0.x, bfhi(vnf[s].x) * e0.y); vs[s].y = cvtpk(bflo(vnf[s].y) * e0.z, bfhi(vnf[s].y) * e0.w);
      vs[s].z = cvtpk(bflo(vnf[s].z) * e1.x, bfhi(vnf[s].z) * e1.y); vs[s].w = cvtpk(bflo(vnf[s].w) * e1.z, bfhi(vnf[s].w) * e1.w);
    }
    {
      u32x4 id1 = {0u, 0u, 0u, 0u}, id2 = {0u, 0u, 0u, 0u};
      {
        const int l15 = l31 & 15;
        const int jsel = (((l15 >> 2) & 1) == hf) ? (4 * (l15 >> 3) + (l15 & 3)) : -1;
        const int j1 = (l31 < 16) ? jsel : -1;
        const int j2 = (l31 >= 16) ? jsel : -1;
        const unsigned one_lo = 0x3f80u, one_hi = 0x3f800000u;
#pragma unroll
        for (int w = 0; w < 4; ++w) {
          id1[w] = (j1 == 2 * w) ? one_lo : ((j1 == 2 * w + 1) ? one_hi : 0u);
          id2[w] = (j2 == 2 * w) ? one_lo : ((j2 == 2 * w + 1) ? one_hi : 0u);
        }
      }
      const bf16x8 B1 = __builtin_bit_cast(bf16x8, id1), B2 = __builtin_bit_cast(bf16x8, id2);
#pragma unroll
      for (int dt = 0; dt < 4; ++dt)
#pragma unroll
        for (int mt = 0; mt < 2; ++mt) {
          f32x16 kt;
#pragma unroll
          for (int r = 0; r < 16; ++r) kt[r] = 0.f;
          const u16* k0 = sk + (32 * mt + l31) * 136 + 32 * dt + 8 * hf;
          kt = mfma32(*(const bf16x8*)(k0), B1, kt);
          kt = mfma32(*(const bf16x8*)(k0 + 16), B2, kt);
#pragma unroll
          for (int s2 = 0; s2 < 2; ++s2) {
            u32x4 af = {cvtpk(kt[8 * s2 + 0], kt[8 * s2 + 1]), cvtpk(kt[8 * s2 + 2], kt[8 * s2 + 3]), cvtpk(kt[8 * s2 + 4], kt[8 * s2 + 5]), cvtpk(kt[8 * s2 + 6], kt[8 * s2 + 7])};
            S[dt] = mfma32(__builtin_bit_cast(bf16x8, af), __builtin_bit_cast(bf16x8, vs[2 * mt + s2]), S[dt]);
          }
        }
    }
    lds_barrier();
  }
}

__device__ __forceinline__ void attn_item(const Params& p, unsigned char* smem, int b, int h, int qb, float lam) {
  int tid_ = ltid();
  const int tid = tid_, lane = tid & 63, wave = tid >> 6;
  const int l31 = lane & 31, hf = lane >> 5;
  const int map = wave >> 1, r0 = (wave & 1) * 32;
  u16* AQ = (u16*)(p.ws + OFF_AQ); const u16* AK = (const u16*)(p.ws + OFF_AK); const u16* AVT = (const u16*)(p.ws + OFF_AVT);
  u16* sK = (u16*)smem;
  float* sO = (float*)smem;
  const int t0 = qb * 64; const int ntiles = qb + 2;
  const size_t qrow = (size_t)(b * LTOK + NMETA + t0 + r0 + l31);
  bf16x8 qf[4];
#pragma unroll
  for (int s = 0; s < 4; ++s) qf[s] = *(const bf16x8*)(AQ + qrow * 1024 + h * 128 + map * 64 + s * 16 + hf * 8);
  f32x16 oacc[4];
#pragma unroll
  for (int d = 0; d < 4; ++d)
#pragma unroll
    for (int r = 0; r < 16; ++r) oacc[d][r] = 0.f;
  float m_run = -1e30f, l_run = 0.f;
  const int qpos = NMETA + t0 + r0 + l31;
  const u16* kbase = AK + ((size_t)b * LPAD) * 1024 + h * 128;
  const u16* vbase = AVT + ((size_t)(b * 8 + h) * 128) * LPAD;
  const int kc = tid & 15, kr = tid >> 4;
  const int vc = tid & 7, vr = tid >> 3;
  u32x4 ak[4], av[4], bk[4], bv[4];
  auto gload = [&](u32x4 (&rk)[4], u32x4 (&rv)[4], int kt) {
#pragma unroll
    for (int i = 0; i < 4; ++i) {
      rk[i] = *(const u32x4*)(kbase + (size_t)(kt * 64 + kr + 16 * i) * 1024 + kc * 8);
      rv[i] = *(const u32x4*)(vbase + (size_t)(vr + 32 * i) * LPAD + kt * 64 + vc * 8);
    }
  };
  auto swrite = [&](const u32x4 (&rk)[4], const u32x4 (&rv)[4], int buf) {
    u16* bK = sK + buf * 17920; u16* bV = bK + 64 * 136;
#pragma unroll
    for (int i = 0; i < 4; ++i) {
      *(u32x4*)(bK + (kr + 16 * i) * 136 + kc * 8) = rk[i];
      u16* dst = bV + (vr + 32 * i) * 72 + (vc >> 1) * 16 + (vc & 1) * 4;
      *(uint2*)dst = make_uint2(rv[i].x, rv[i].y); *(uint2*)(dst + 8) = make_uint2(rv[i].z, rv[i].w);
    }
  };
  auto compute = [&](int kt, int buf) {
    const u16* bK = sK + buf * 17920; const u16* bV = bK + 64 * 136;
    f32x16 st[2];
#pragma unroll
    for (int mt = 0; mt < 2; ++mt) {
#pragma unroll
      for (int r = 0; r < 16; ++r) st[mt][r] = 0.f;
#pragma unroll
      for (int s = 0; s < 4; ++s) {
        bf16x8 kf = *(const bf16x8*)(bK + (mt * 32 + l31) * 136 + map * 64 + s * 16 + hf * 8);
        st[mt] = mfma32(kf, qf[s], st[mt]);
      }
    }
    if (kt >= ntiles - 2) {
#pragma unroll
      for (int mt = 0; mt < 2; ++mt)
#pragma unroll
        for (int r = 0; r < 16; ++r) {
          int key = kt * 64 + mt * 32 + 8 * (r >> 2) + 4 * hf + (r & 3);
          if (key > qpos) st[mt][r] = -1e30f;
        }
    }
    float mx = -1e30f;
#pragma unroll
    for (int mt = 0; mt < 2; ++mt)
#pragma unroll
      for (int r = 0; r < 16; ++r) mx = fmaxf(mx, st[mt][r]);
    mx = fmaxf(mx, __shfl_xor(mx, 32));
    const float m_new = fmaxf(m_run, mx);
    const float alpha = __builtin_amdgcn_exp2f(m_run - m_new);
    float rsum = 0.f;
#pragma unroll
    for (int mt = 0; mt < 2; ++mt)
#pragma unroll
      for (int r = 0; r < 16; ++r) { float pv = __builtin_amdgcn_exp2f(st[mt][r] - m_new); st[mt][r] = pv; rsum += pv; }
    l_run = l_run * alpha + rsum; m_run = m_new;
#pragma unroll
    for (int d = 0; d < 4; ++d)
#pragma unroll
      for (int r = 0; r < 16; ++r) oacc[d][r] *= alpha;
#pragma unroll
    for (int s = 0; s < 4; ++s) {
      const int mt = s >> 1, ss = s & 1;
      u32x4 pt = {cvtpk(st[mt][8 * ss + 0], st[mt][8 * ss + 1]), cvtpk(st[mt][8 * ss + 2], st[mt][8 * ss + 3]),
                  cvtpk(st[mt][8 * ss + 4], st[mt][8 * ss + 5]), cvtpk(st[mt][8 * ss + 6], st[mt][8 * ss + 7])};
      bf16x8 pf = __builtin_bit_cast(bf16x8, pt);
#pragma unroll
      for (int d = 0; d < 4; ++d) {
        const bf16x8 vf = *(const bf16x8*)(bV + (d * 32 + l31) * 72 + mt * 32 + ss * 16 + hf * 8);
        oacc[d] = mfma32(vf, pf, oacc[d]);
      }
    }
  };
  gload(ak, av, 0); swrite(ak, av, 0); gload(bk, bv, 1);
  lds_barrier();
#pragma unroll 1
  for (int kt = 0; kt < ntiles; kt += 2) {
    if (kt + 2 < ntiles) gload(ak, av, kt + 2);
    compute(kt, 0);
    if (kt + 1 < ntiles) swrite(bk, bv, 1);
    lds_barrier();
    if (kt + 1 < ntiles) {
      if (kt + 3 < ntiles) gload(bk, bv, kt + 3);
      compute(kt + 1, 1);
      if (kt + 2 < ntiles) swrite(ak, av, 0);
      lds_barrier();
    }
  }
  const float l_tot = l_run + __shfl_xor(l_run, 32);
  const float inv = 1.f / l_tot;
#pragma unroll
  for (int d = 0; d < 4; ++d)
#pragma unroll
    for (int g = 0; g < 4; ++g) {
      float4 o4 = make_float4(oacc[d][4 * g] * inv, oacc[d][4 * g + 1] * inv, oacc[d][4 * g + 2] * inv, oacc[d][4 * g + 3] * inv);
      *(float4*)(sO + ((map * 64 + r0 + l31) * 132 + d * 32 + 8 * g + 4 * hf)) = o4;
    }
  __syncthreads();
  {
    const int q = tid >> 2, qq = tid & 3;
    const float4* o0 = (const float4*)(sO + (q * 132 + qq * 32)); const float4* o1 = (const float4*)(sO + ((64 + q) * 132 + qq * 32));
    float ss = 0.f;
#pragma unroll
    for (int i = 0; i < 8; ++i) {
      float4 a = o0[i], c = o1[i];
      float dx = a.x - lam * c.x, dy = a.y - lam * c.y, dz = a.z - lam * c.z, dw = a.w - lam * c.w;
      ss += dx * dx + dy * dy + dz * dz + dw * dw;
    }
    ss += __shfl_xor(ss, 1); ss += __shfl_xor(ss, 2);
    const float rsn = rsqrtf(ss * (1.f / 128.f) + 1e-6f) * 0.8f;
    const float4* nw = (const float4*)(p.attn_norm_w + qq * 32);
    uint4* dst = (uint4*)(AQ + (size_t)(b * LTOK + NMETA + t0 + q) * 1024 + h * 128 + qq * 32);
#pragma unroll
    for (int i = 0; i < 4; ++i) {
      float4 a0 = o0[2 * i], c0 = o1[2 * i], a1 = o0[2 * i + 1], c1 = o1[2 * i + 1];
      float4 w0 = nw[2 * i], w1 = nw[2 * i + 1];
      uint4 o;
      o.x = cvtpk((a0.x - lam * c0.x) * rsn * w0.x, (a0.y - lam * c0.y) * rsn * w0.y);
      o.y = cvtpk((a0.z - lam * c0.z) * rsn * w0.z, (a0.w - lam * c0.w) * rsn * w0.w);
      o.z = cvtpk((a1.x - lam * c1.x) * rsn * w1.x, (a1.y - lam * c1.y) * rsn * w1.y);
      o.w = cvtpk((a1.z - lam * c1.z) * rsn * w1.z, (a1.w - lam * c1.w) * rsn * w1.w);
      dst[i] = o;
    }
  }
  __syncthreads();
}

__device__ __forceinline__ void phase3(const Params& p, unsigned char* smem, unsigned* bar) {
  __shared__ int s_item;
  const int tid = ltid();
  const bool is_scan = (blockIdx.x < 16);
  if (is_scan) {
    f32x16 S[4];
#pragma unroll
    for (int d = 0; d < 4; ++d)
#pragma unroll
      for (int r = 0; r < 16; ++r) S[d][r] = 0.f;
    scan_chunked(p, smem, blockIdx.x, S, 0, NCH);
  } else {
    phase2<true>(p, smem, P2_SPLIT * 16, NCH * 16, blockIdx.x - 16, gridDim.x - 16);
  }
  int* cnt = (int*)(p.ws + OFF_CTL);
  const float lam = ((const float*)(p.ws + OFF_CTL))[16];
  const int myq = blockIdx.x & 7;
  for (int qq = 0; qq < 8; ++qq) {
    const int q = (myq + qq) & 7;
    while (true) {
      if (tid == 0) s_item = atomicAdd(&cnt[q], 1);
      __syncthreads();
      const int idx = s_item;
      __syncthreads();
      if (idx >= 256) break;
      attn_item(p, smem, idx & 1, q, 127 - (idx >> 1), lam);
    }
  }
}

__device__ __forceinline__ int tokrow_of(int m) { int b = m >> 13; return b * LTOK + NMETA + (m & 8191); }

__device__ __forceinline__ void phase4(const Params& p, unsigned char* smem) {
  const u16* hn = (const u16*)p.out; const u16* wtin = hn + (size_t)NTOK * DM;
  u16* AQ = (u16*)(p.ws + OFF_AQ); u16* DX = (u16*)(p.ws + OFF_DX);
  u16* SGA = (u16*)(p.ws + OFF_AK); u16* SGD = (u16*)(p.ws + OFF_AVT);
  const int xcd = blockIdx.x & 7, lw = blockIdx.x >> 3, LW = (gridDim.x - xcd + 7) >> 3;
  for (int i = lw;; i += LW) {
    int mt, nt; if (!tile_map(i, xcd, 128, 32, mt, nt)) break;
    const int m0 = mt * 128;
    const int n0 = nt < 8 ? 3072 + nt * 128 : (nt < 16 ? 7168 + (nt - 8) * 128 : 8208 + (nt - 16) * 128);
    f32x16 acc[2][2]; zero_acc(acc);
    gemm_kloop(acc, [&](int m) { return hn + (size_t)tokrow_of(m) * DM; }, [](int k0) { return (size_t)k0; }, wtin, m0, n0, smem);
    if (nt < 8) {
      epilogue_rows(acc, m0, n0, smem, [&](int m, int n, float4 a, float4 b) {
        uint4* ptr = (uint4*)(AQ + (size_t)tokrow_of(m) * 1024 + (n - 3072));
        uint4 o = *ptr;
        a.x = bflo(o.x) * siluf_(a.x); a.y = bfhi(o.x) * siluf_(a.y); a.z = bflo(o.y) * siluf_(a.z); a.w = bfhi(o.y) * siluf_(a.w);
        b.x = bflo(o.z) * siluf_(b.x); b.y = bfhi(o.z) * siluf_(b.y); b.z = bflo(o.w) * siluf_(b.z); b.w = bfhi(o.w) * siluf_(b.w);
        *ptr = pack8(a, b);
      });
    } else if (nt < 16) {
      epilogue_rows(acc, m0, n0, smem, [&](int m, int n, float4 a, float4 b) {
        int col = n - 7168; int h = col >> 7, d = col & 127;
        int bb = m >> 13, t = m & 8191; int bh = bb * 8 + h; int pp = t + 64;
        uint4* ptr = (uint4*)(DX + (((size_t)(bh * NCH + (pp >> 6))) * 3) * 8192 + (pp & 63) * 128 + d);
        uint4 o = *ptr;
        float o0 = bflo(o.x), o1 = bfhi(o.x), o2 = bflo(o.y), o3 = bfhi(o.y), o4 = bflo(o.z), o5 = bfhi(o.z), o6 = bflo(o.w), o7 = bfhi(o.w);
        float sq = o0 * o0 + o1 * o1 + o2 * o2 + o3 * o3 + o4 * o4 + o5 * o5 + o6 * o6 + o7 * o7;
        sq += __shfl_xor(sq, 1); sq += __shfl_xor(sq, 2); sq += __shfl_xor(sq, 4); sq += __shfl_xor(sq, 8);
        float rs = rsqrtf(sq * (1.f / 128.f) + 1e-6f);
        float4 w0 = *(const float4*)(p.dn_norm_w + d), w1 = *(const float4*)(p.dn_norm_w + d + 4);
        a.x = o0 * rs * w0.x * siluf_(a.x); a.y = o1 * rs * w0.y * siluf_(a.y); a.z = o2 * rs * w0.z * siluf_(a.z); a.w = o3 * rs * w0.w * siluf_(a.w);
        b.x = o4 * rs * w1.x * siluf_(b.x); b.y = o5 * rs * w1.y * siluf_(b.y); b.z = o6 * rs * w1.z * siluf_(b.z); b.w = o7 * rs * w1.w * siluf_(b.w);
        *ptr = pack8(a, b);
      });
    } else {
      epilogue_rows(acc, m0, n0, smem, [&](int m, int n, float4 a, float4 b) {
        int col = n - 8208; u16* dst = col < 1024 ? SGA + col : SGD + (col - 1024);
        a.x = sigmoidf_(a.x); a.y = sigmoidf_(a.y); a.z = sigmoidf_(a.z); a.w = sigmoidf_(a.w);
        b.x = sigmoidf_(b.x); b.y = sigmoidf_(b.y); b.z = sigmoidf_(b.z); b.w = sigmoidf_(b.w);
        *(uint4*)(dst + (size_t)m * 1024) = pack8(a, b);
      });
    }
  }
}

__device__ __forceinline__ void phase5(const Params& p, unsigned char* smem) {
  const u16* AQ = (const u16*)(p.ws + OFF_AQ); const u16* DX = (const u16*)(p.ws + OFF_DX);
  const u16* SGA = (const u16*)(p.ws + OFF_AK); const u16* SGD = (const u16*)(p.ws + OFF_AVT);
  const u16* wat = (const u16*)(p.ws + OFF_W3); const u16* wdt = wat + 1024 * 1024;
  u16* MERGED = (u16*)(p.ws + OFF_EXTRA);
  const int xcd = blockIdx.x & 7, lw = blockIdx.x >> 3, LW = (gridDim.x - xcd + 7) >> 3;
  for (int i = lw;; i += LW) {
    int mt, nt; if (!tile_map(i, xcd, 128, 8, mt, nt)) break;
    const int m0 = mt * 128, n0 = nt * 128;
    f32x16 acc[2][2]; zero_acc(acc);
    gemm_kloop(acc, [&](int m) { return AQ + (size_t)tokrow_of(m) * 1024; }, [](int k0) { return (size_t)k0; }, wat, m0, n0, smem);
    epilogue_rows(acc, m0, n0, smem, [&](int m, int n, float4 a, float4 b) {
      uint4 g = *(const uint4*)(SGA + (size_t)m * 1024 + n);
      a.x *= bflo(g.x); a.y *= bfhi(g.x); a.z *= bflo(g.y); a.w *= bfhi(g.y); b.x *= bflo(g.z); b.y *= bfhi(g.z); b.z *= bflo(g.w); b.w *= bfhi(g.w);
      *(uint4*)(MERGED + (size_t)m * 1024 + n) = pack8(a, b);
    });
  }
  for (int i = lw;; i += LW) {
    int mt, nt; if (!tile_map(i, xcd, 128, 8, mt, nt)) break;
    const int m0 = mt * 128, n0 = nt * 128;
    f32x16 acc[2][2]; zero_acc(acc);
    gemm_kloop(acc, [&](int m) {
      int bb = m >> 13, t = m & 8191; int pp = t + 64;
      return DX + (((size_t)((bb * 8) * NCH + (pp >> 6))) * 3) * 8192 + (pp & 63) * 128;
    }, [](int k0) { return (size_t)(k0 >> 7) * ((size_t)NCH * 3 * 8192) + (size_t)(k0 & 127); }, wdt, m0, n0, smem);
    epilogue_rows(acc, m0, n0, smem, [&](int m, int n, float4 a, float4 b) {
      uint4 g = *(const uint4*)(SGD + (size_t)m * 1024 + n);
      uint4* ptr = (uint4*)(MERGED + (size_t)m * 1024 + n);
      uint4 o = *ptr;
      a.x = bflo(o.x) + a.x * bflo(g.x); a.y = bfhi(o.x) + a.y * bfhi(g.x); a.z = bflo(o.y) + a.z * bflo(g.y); a.w = bfhi(o.y) + a.w * bfhi(g.y);
      b.x = bflo(o.z) + b.x * bflo(g.z); b.y = bfhi(o.z) + b.y * bfhi(g.z); b.z = bflo(o.w) + b.z * bflo(g.w); b.w = bfhi(o.w) + b.w * bfhi(g.w);
      *ptr = pack8(a, b);
    });
  }
}

__device__ __forceinline__ void phase6(const Params& p, unsigned char* smem) {
  const u16* MERGED = (const u16*)(p.ws + OFF_EXTRA);
  const u16* wot = (const u16*)(p.ws + OFF_W3) + 2 * 1024 * 1024;
  float* PSUM = (float*)(p.ws + OFF_PSUM);
  const int xcd = blockIdx.x & 7, lw = blockIdx.x >> 3, LW = (gridDim.x - xcd + 7) >> 3;
  for (int i = lw;; i += LW) {
    int mt, nt; if (!tile_map(i, xcd, 128, 8, mt, nt)) break;
    const int m0 = mt * 128, n0 = nt * 128;
    f32x16 acc[2][2]; zero_acc(acc);
    gemm_kloop(acc, [&](int m) { return MERGED + (size_t)m * 1024; }, [](int k0) { return (size_t)k0; }, wot, m0, n0, smem);
    epilogue_rows(acc, m0, n0, smem, [&](int m, int n, float4 a, float4 b) {
      const float4* xp = (const float4*)(p.x + (size_t)m * 1024 + n);
      float4 x0 = xp[0], x1 = xp[1];
      a.x += x0.x; a.y += x0.y; a.z += x0.z; a.w += x0.w; b.x += x1.x; b.y += x1.y; b.z += x1.z; b.w += x1.w;
      float4* op = (float4*)(p.out + (size_t)m * 1024 + n);
      op[0] = a; op[1] = b;
      float sq = a.x * a.x + a.y * a.y + a.z * a.z + a.w * a.w + b.x * b.x + b.y * b.y + b.z * b.z + b.w * b.w;
      sq += __shfl_xor(sq, 1); sq += __shfl_xor(sq, 2); sq += __shfl_xor(sq, 4); sq += __shfl_xor(sq, 8);
      if ((ltid() & 15) == 0) PSUM[(size_t)nt * NX + m] = sq;
    });
  }
}

__device__ __forceinline__ void phase7(const Params& p) {
  const float* PSUM = (const float*)(p.ws + OFF_PSUM);
  const int tid__ = ltid(); const int lane = tid__ & 63, wave = tid__ >> 6;
  for (int it = blockIdx.x; it < NX / 4; it += gridDim.x) {
    int row = it * 4 + wave;
    float tot = 0.f;
#pragma unroll
    for (int j = 0; j < 8; ++j) tot += PSUM[(size_t)j * NX + row];
    float rs = rsqrtf(tot * (1.f / 1024.f) + 1e-6f);
    float4* o = (float4*)(p.out + (size_t)row * 1024);
#pragma unroll
    for (int i = 0; i < 4; ++i) {
      float4 v = o[lane + 64 * i]; float4 w = ((const float4*)p.final_w)[lane + 64 * i];
      v.x *= rs * w.x; v.y *= rs * w.y; v.z *= rs * w.z; v.w *= rs * w.w;
      o[lane + 64 * i] = v;
    }
  }
}

__global__ void __launch_bounds__(256, 2) mega(Params p) {
  extern __shared__ __attribute__((aligned(16))) unsigned char smem[];
  cg::grid_group grid = cg::this_grid();
  unsigned* bar = (unsigned*)(p.ws + OFF_BAR);
  phase0(p, smem); grid.sync();
  unsigned bk = 0;
  phase1(p, smem); grid_barrier(bar, ++bk);
  if (P2_SPLIT > 0) { phase2<false>(p, smem, 0, P2_SPLIT * 16, blockIdx.x, gridDim.x); grid_barrier(bar, ++bk); }
  phase3(p, smem, bar); grid_barrier(bar, ++bk);
  phase4(p, smem); grid_barrier(bar, ++bk);
  phase5(p, smem); grid_barrier(bar, ++bk);
  phase6(p, smem); grid_barrier(bar, ++bk);
  phase7(p);
}

extern "C" void kernel_launch(void* const* d_in, const int* in_sizes, int n_in, void* d_out, int out_size, void* d_ws, size_t ws_size, hipStream_t stream) {
  static int grid_blocks = 0;
  if (!grid_blocks) {
    int dev = 0, cus = 0, per_cu = 0;
    hipGetDevice(&dev);
    hipDeviceGetAttribute(&cus, hipDeviceAttributeMultiprocessorCount, dev);
    hipFuncSetAttribute((const void*)mega, hipFuncAttributeMaxDynamicSharedMemorySize, SMEM_BYTES);
    hipOccupancyMaxActiveBlocksPerMultiprocessor(&per_cu, (const void*)mega, 256, SMEM_BYTES);
    if (per_cu < 1) per_cu = 1;
    if (per_cu > 2) per_cu = 2;
    grid_blocks = cus * per_cu;
    if (ws_size < WS_END) fprintf(stderr, "workspace too small: %zu < %zu\n", ws_size, (size_t)WS_END);
  }
  Params p{};
  p.x = (const float*)d_in[0]; p.meta = (const float*)d_in[1]; p.norm_w = (const float*)d_in[2]; p.w_in = (const float*)d_in[3];
  p.lq1 = (const float*)d_in[4]; p.lk1 = (const float*)d_in[5]; p.lq2 = (const float*)d_in[6]; p.lk2 = (const float*)d_in[7];
  p.attn_norm_w = (const float*)d_in[8]; p.conv_w = (const float*)d_in[9]; p.a_log = (const float*)d_in[10]; p.dt_bias = (const float*)d_in[11];
  p.dn_norm_w = (const float*)d_in[12]; p.w_a = (const float*)d_in[13]; p.w_d = (const float*)d_in[14]; p.w_o = (const float*)d_in[15]; p.final_w = (const float*)d_in[16];
  p.out = (float*)d_out; p.ws = (unsigned char*)d_ws;
  hipMemsetAsync((unsigned char*)d_ws + OFF_BAR, 0, 2048, stream);
  void* args[] = {&p};
  hipError_t e = hipLaunchCooperativeKernel((const void*)mega, dim3(grid_blocks), dim3(256), args, SMEM_BYTES, stream);
  if (e != hipSuccess) fprintf(stderr, "cooperative launch failed: %s (grid %d)\n", hipGetErrorString(e), grid_blocks);
}
```

```cpp
#include <hip/hip_runtime.h>
#include <hip/hip_cooperative_groups.h>
#include <stdint.h>
#include <stdio.h>
namespace cg = cooperative_groups;

typedef unsigned short u16;
typedef __attribute__((ext_vector_type(8))) short bf16x8;
typedef __attribute__((ext_vector_type(16))) float f32x16;
typedef __attribute__((ext_vector_type(4))) unsigned u32x4;

constexpr int SEQ = 8192, NMETA = 16, LTOK = 8208, DM = 1024, NTOK = 16416, NX = 16384;
constexpr int LPAD = 8256, NCH = 129, INDIM = 10256;
constexpr float QSCALE = 0.125f * 1.44269504088896f;

constexpr size_t OFF_AQ = 0;
constexpr size_t OFF_AK = 33619968;
constexpr size_t OFF_AVT = 67436544;
constexpr size_t OFF_DX = 101253120;
constexpr size_t OFF_HALO = 202702848;
constexpr size_t OFF_EXTRA = 207458304;
constexpr size_t OFF_W3 = 243388416;
constexpr size_t OFF_BETA = 249679872;
constexpr size_t OFF_G = 250208256;
constexpr size_t OFF_PSQ = 250736640;
constexpr size_t OFF_PSUM = 252850176;
constexpr size_t OFF_CTL = 253898752;
constexpr size_t WS_END = 253902848;
constexpr size_t OFF_BAR = OFF_CTL + 2048;
constexpr int SMEM_BYTES = 73728;
constexpr int P2_SPLIT = 0;

struct Params {
  const float* x; const float* meta; const float* norm_w; const float* w_in;
  const float* lq1; const float* lk1; const float* lq2; const float* lk2;
  const float* attn_norm_w; const float* conv_w; const float* a_log; const float* dt_bias;
  const float* dn_norm_w; const float* w_a; const float* w_d; const float* w_o; const float* final_w;
  float* out; unsigned char* ws;
};

typedef __bf16 bf16x2_t __attribute__((ext_vector_type(2)));
typedef float f32x2_t __attribute__((ext_vector_type(2)));
__device__ __forceinline__ unsigned cvtpk(float lo, float hi) { f32x2_t v = {lo, hi}; bf16x2_t b = __builtin_convertvector(v, bf16x2_t); return __builtin_bit_cast(unsigned, b); }
__device__ __forceinline__ u16 f2bf(float f) { return (u16)(cvtpk(f, 0.f) & 0xffffu); }
__device__ __forceinline__ float bf2f(u16 v) { return __uint_as_float(((unsigned)v) << 16); }
__device__ __forceinline__ float bflo(unsigned v) { return __uint_as_float(v << 16); }
__device__ __forceinline__ float bfhi(unsigned v) { return __uint_as_float(v & 0xffff0000u); }
__device__ __forceinline__ float sigmoidf_(float x) { return 1.f / (1.f + __expf(-x)); }
__device__ __forceinline__ float siluf_(float x) { return x / (1.f + __expf(-x)); }
__device__ __forceinline__ f32x16 mfma32(bf16x8 a, bf16x8 b, f32x16 c) { return __builtin_amdgcn_mfma_f32_32x32x16_bf16(a, b, c, 0, 0, 0); }
__device__ __forceinline__ float wave_sum(float v) {
#pragma unroll
  for (int o = 32; o > 0; o >>= 1) v += __shfl_xor(v, o);
  return v;
}

__device__ __forceinline__ int ltid() { int t = threadIdx.x; asm volatile("" : "+v"(t)); return t; }

__device__ __forceinline__ void lds_barrier() { asm volatile("s_waitcnt lgkmcnt(0)\n\ts_barrier" ::: "memory"); }

__device__ __forceinline__ void grid_barrier(unsigned* ctr, const unsigned k) {
  __syncthreads();
  if (threadIdx.x == 0) {
    __hip_atomic_fetch_add(ctr, 1u, __ATOMIC_RELEASE, __HIP_MEMORY_SCOPE_AGENT);
    const unsigned target = k * gridDim.x;
    while (__hip_atomic_load(ctr, __ATOMIC_RELAXED, __HIP_MEMORY_SCOPE_AGENT) < target) __builtin_amdgcn_s_sleep(1);
    __builtin_amdgcn_fence(__ATOMIC_ACQUIRE, "agent");
  }
  __syncthreads();
}

__device__ __forceinline__ bool tile_map(int i, int xcd, int MT, int NT, int& mt, int& nt) {
  int cm = (MT - xcd + 7) >> 3;
  int ag = i / (8 * NT);
  if (ag * 8 >= cm) return false;
  int gs = cm - ag * 8; if (gs > 8) gs = 8;
  int j = i - ag * 8 * NT;
  if (j >= gs * NT) return false;
  int al = j % gs; nt = j / gs;
  mt = xcd + 8 * (8 * ag + al);
  return true;
}

template <class ARowF, class KOffF>
__device__ __forceinline__ void gemm_kloop(f32x16 (&acc)[2][2], ARowF arow, KOffF koff, const u16* __restrict__ Bt, int m0, int n0, unsigned char* smem) {
  const int tid = ltid(), lane = tid & 63, wave = tid >> 6;
  const int wm = wave >> 1, wn = wave & 1;
  const int lr = tid >> 3, lc = tid & 7;
  const int l31 = lane & 31, hf = lane >> 5;
  u16* sA = (u16*)smem; u16* sB = sA + 2 * 128 * 72;
  const u16* pa0 = arow(m0 + lr) + lc * 8; const u16* pa1 = arow(m0 + lr + 32) + lc * 8;
  const u16* pa2 = arow(m0 + lr + 64) + lc * 8; const u16* pa3 = arow(m0 + lr + 96) + lc * 8;
  const u16* pb0 = Bt + (size_t)(n0 + lr) * 1024 + lc * 8;
  u32x4 ra0, ra1, ra2, ra3, rb0, rb1, rb2, rb3;
  {
    const size_t ko = koff(0);
    ra0 = *(const u32x4*)(pa0 + ko); ra1 = *(const u32x4*)(pa1 + ko); ra2 = *(const u32x4*)(pa2 + ko); ra3 = *(const u32x4*)(pa3 + ko);
    rb0 = *(const u32x4*)(pb0); rb1 = *(const u32x4*)(pb0 + 32 * 1024); rb2 = *(const u32x4*)(pb0 + 64 * 1024); rb3 = *(const u32x4*)(pb0 + 96 * 1024);
  }
  u16* wA0 = sA + lr * 72 + lc * 8; u16* wB0 = sB + lr * 72 + lc * 8;
  *(u32x4*)(wA0) = ra0; *(u32x4*)(wA0 + 32 * 72) = ra1; *(u32x4*)(wA0 + 64 * 72) = ra2; *(u32x4*)(wA0 + 96 * 72) = ra3;
  *(u32x4*)(wB0) = rb0; *(u32x4*)(wB0 + 32 * 72) = rb1; *(u32x4*)(wB0 + 64 * 72) = rb2; *(u32x4*)(wB0 + 96 * 72) = rb3;
  lds_barrier();
#pragma unroll 1
  for (int kt = 0; kt < 16; ++kt) {
    const int buf = kt & 1;
    if (kt + 1 < 16) {
      const size_t ko = koff((kt + 1) * 64); const int kb = (kt + 1) * 64;
      ra0 = *(const u32x4*)(pa0 + ko); ra1 = *(const u32x4*)(pa1 + ko); ra2 = *(const u32x4*)(pa2 + ko); ra3 = *(const u32x4*)(pa3 + ko);
      rb0 = *(const u32x4*)(pb0 + kb); rb1 = *(const u32x4*)(pb0 + 32 * 1024 + kb); rb2 = *(const u32x4*)(pb0 + 64 * 1024 + kb); rb3 = *(const u32x4*)(pb0 + 96 * 1024 + kb);
    }
    const u16* cA = sA + buf * 128 * 72 + (wm * 64 + l31) * 72 + hf * 8;
    const u16* cB = sB + buf * 128 * 72 + (wn * 64 + l31) * 72 + hf * 8;
    __builtin_amdgcn_s_setprio(1);
#pragma unroll
    for (int ks = 0; ks < 4; ++ks) {
      bf16x8 a0 = *(const bf16x8*)(cA + ks * 16);
      bf16x8 a1 = *(const bf16x8*)(cA + 32 * 72 + ks * 16);
      bf16x8 b0 = *(const bf16x8*)(cB + ks * 16);
      bf16x8 b1 = *(const bf16x8*)(cB + 32 * 72 + ks * 16);
      acc[0][0] = mfma32(a0, b0, acc[0][0]);
      acc[0][1] = mfma32(a0, b1, acc[0][1]);
      acc[1][0] = mfma32(a1, b0, acc[1][0]);
      acc[1][1] = mfma32(a1, b1, acc[1][1]);
    }
    __builtin_amdgcn_s_setprio(0);
    if (kt + 1 < 16) {
      u16* wA = wA0 + (buf ^ 1) * 128 * 72; u16* wB = wB0 + (buf ^ 1) * 128 * 72;
      *(u32x4*)(wA) = ra0; *(u32x4*)(wA + 32 * 72) = ra1; *(u32x4*)(wA + 64 * 72) = ra2; *(u32x4*)(wA + 96 * 72) = ra3;
      *(u32x4*)(wB) = rb0; *(u32x4*)(wB + 32 * 72) = rb1; *(u32x4*)(wB + 64 * 72) = rb2; *(u32x4*)(wB + 96 * 72) = rb3;
    }
    lds_barrier();
  }
}

__device__ __forceinline__ void stage_acc(f32x16 (&acc)[2][2], float* sC) {
  const int tid__ = ltid(); const int lane = tid__ & 63, wave = tid__ >> 6;
  const int wm = wave >> 1, wn = wave & 1, l31 = lane & 31, hf = lane >> 5;
  float* base = sC + (wm * 64 + 4 * hf) * 132 + wn * 64 + l31;
#pragma unroll
  for (int mi = 0; mi < 2; ++mi)
#pragma unroll
    for (int ni = 0; ni < 2; ++ni)
#pragma unroll
      for (int r = 0; r < 16; ++r) base[(mi * 32 + 8 * (r >> 2) + (r & 3)) * 132 + ni * 32] = acc[mi][ni][r];
  __syncthreads();
}
template <class Epi>
__device__ __forceinline__ void epilogue_rows(f32x16 (&acc)[2][2], int m0, int n0, unsigned char* smem, Epi epi) {
  float* sC = (float*)smem;
  stage_acc(acc, sC);
  const int tid = ltid();
#pragma unroll 2
  for (int it = 0; it < 8; ++it) {
    int idx = tid + 256 * it; int r = idx >> 4, c8 = (idx & 15) * 8;
    float4 a = *(const float4*)(sC + r * 132 + c8), b = *(const float4*)(sC + r * 132 + c8 + 4);
    epi(m0 + r, n0 + c8, a, b);
  }
  __syncthreads();
}
template <class Epi>
__device__ __forceinline__ void epilogue_cols(f32x16 (&acc)[2][2], int m0, int n0, unsigned char* smem, Epi epi) {
  float* sC = (float*)smem;
  stage_acc(acc, sC);
  const int tid = ltid();
#pragma unroll 2
  for (int it = 0; it < 8; ++it) {
    int idx = tid + 256 * it; int n = idx & 127, r8 = (idx >> 7) * 8;
    const float* s = sC + r8 * 132 + n;
    float4 a = make_float4(s[0], s[132], s[264], s[396]), b = make_float4(s[528], s[660], s[792], s[924]);
    epi(m0 + r8, n0 + n, a, b);
  }
  __syncthreads();
}
__device__ __forceinline__ uint4 pack8(float4 a, float4 b) { uint4 o; o.x = cvtpk(a.x, a.y); o.y = cvtpk(a.z, a.w); o.z = cvtpk(b.x, b.y); o.w = cvtpk(b.z, b.w); return o; }

__device__ __forceinline__ void zero_acc(f32x16 (&acc)[2][2]) {
#pragma unroll
  for (int a = 0; a < 2; ++a)
#pragma unroll
    for (int b = 0; b < 2; ++b)
#pragma unroll
      for (int r = 0; r < 16; ++r) acc[a][b][r] = 0.f;
}

__device__ __forceinline__ void phase0(const Params& p, unsigned char* smem) {
  u16* hn = (u16*)p.out; u16* wtin = hn + (size_t)NTOK * DM;
  u16* w3 = (u16*)(p.ws + OFF_W3);
  const int tid = ltid(), lane = tid & 63, wave = tid >> 6;
  constexpr int N_HN = NTOK / 4;
  constexpr int NT_IN = 161;
  constexpr int N_TR = 16 * NT_IN + 3 * 256;
  constexpr int N_MISC = 16;
  for (int it = blockIdx.x; it < N_HN + N_TR + N_MISC; it += gridDim.x) {
    if (it < N_HN) {
      int row = it * 4 + wave; int b = row / LTOK, pos = row - b * LTOK;
      const float* src = pos < NMETA ? p.meta + pos * DM : p.x + ((size_t)b * SEQ + pos - NMETA) * DM;
      float4 v[4]; float ss = 0.f;
#pragma unroll
      for (int i = 0; i < 4; ++i) { v[i] = ((const float4*)src)[lane + 64 * i]; ss += v[i].x * v[i].x + v[i].y * v[i].y + v[i].z * v[i].z + v[i].w * v[i].w; }
      ss = wave_sum(ss);
      float rs = rsqrtf(ss * (1.f / 1024.f) + 1e-6f);
#pragma unroll
      for (int i = 0; i < 4; ++i) {
        float4 w = ((const float4*)p.norm_w)[lane + 64 * i];
        uint2 o; o.x = cvtpk(v[i].x * rs * w.x, v[i].y * rs * w.y); o.y = cvtpk(v[i].z * rs * w.z, v[i].w * rs * w.w);
        ((uint2*)(hn + (size_t)row * DM))[lane + 64 * i] = o;
      }
    } else if (it < N_HN + N_TR) {
      int j = it - N_HN; const float* W; u16* Wt; int N, kt, nt;
      if (j < 16 * NT_IN) { W = p.w_in; Wt = wtin; N = INDIM; kt = j / NT_IN; nt = j - kt * NT_IN; }
      else { j -= 16 * NT_IN; int mtx = j >> 8; j &= 255; W = mtx == 0 ? p.w_a : (mtx == 1 ? p.w_d : p.w_o); Wt = w3 + (size_t)mtx * 1024 * 1024; N = 1024; kt = j >> 4; nt = j & 15; }
      float* tile = (float*)smem;
#pragma unroll
      for (int i = 0; i < 16; ++i) {
        int k = (tid >> 6) + 4 * i; int n = nt * 64 + (tid & 63);
        tile[k * 65 + (tid & 63)] = n < N ? W[(size_t)(kt * 64 + k) * N + n] : 0.f;
      }
      __syncthreads();
      int kk2 = (tid & 31) * 2;
#pragma unroll
      for (int i = 0; i < 8; ++i) {
        int jj = (tid >> 5) + 8 * i; int n = nt * 64 + jj;
        if (n < N) *(unsigned*)(Wt + (size_t)n * 1024 + kt * 64 + kk2) = cvtpk(tile[kk2 * 65 + jj], tile[(kk2 + 1) * 65 + jj]);
      }
      __syncthreads();
    } else {
      int mi = it - N_HN - N_TR;
      unsigned* ak = (unsigned*)(p.ws + OFF_AK); unsigned* avt = (unsigned*)(p.ws + OFF_AVT);
      for (int idx = mi * 256 + tid; idx < 2 * 48 * 512; idx += N_MISC * 256) {
        int b = idx / (48 * 512), r = idx - b * 48 * 512;
        ak[((size_t)b * LPAD + LTOK) * 512 + r] = 0u;
      }
      for (int idx = mi * 256 + tid; idx < 2048 * 24; idx += N_MISC * 256) {
        int row = idx / 24, c = idx - row * 24;
        avt[(size_t)row * (LPAD / 2) + LTOK / 2 + c] = 0u;
      }
      if (mi == 0) {
        int* ctl = (int*)(p.ws + OFF_CTL);
        if (tid < 16) ctl[tid] = 0;
        if (wave == 1) {
          float a = p.lq1[lane] * p.lk1[lane], c = p.lq2[lane] * p.lk2[lane];
          a = wave_sum(a); c = wave_sum(c);
          if (lane == 0) ((float*)ctl)[16] = __expf(a) - __expf(c) + 0.2f;
        }
      }
    }
  }
}

__device__ __forceinline__ void phase1(const Params& p, unsigned char* smem) {
  const u16* hn = (const u16*)p.out; const u16* wtin = hn + (size_t)NTOK * DM;
  u16* AQ = (u16*)(p.ws + OFF_AQ); u16* AK = (u16*)(p.ws + OFF_AK); u16* AVT = (u16*)(p.ws + OFF_AVT);
  u16* DX = (u16*)(p.ws + OFF_DX); u16* HALO = (u16*)(p.ws + OFF_HALO);
  float* BETA = (float*)(p.ws + OFF_BETA); float* GG = (float*)(p.ws + OFF_G);
  const int xcd = blockIdx.x & 7, lw = blockIdx.x >> 3, LW = (gridDim.x - xcd + 7) >> 3;
  for (int i = lw;; i += LW) {
    int mt, nt; if (!tile_map(i, xcd, 129, 49, mt, nt)) break;
    const int m0 = mt * 128;
    const int n0 = nt < 24 ? nt * 128 : (nt < 48 ? 4096 + (nt - 24) * 128 : 8192);
    f32x16 acc[2][2]; zero_acc(acc);
    gemm_kloop(acc, [&](int m) { int mm = m < NTOK ? m : NTOK - 1; return hn + (size_t)mm * DM; }, [](int k0) { return (size_t)k0; }, wtin, m0, n0, smem);
    if (nt < 8) {
      epilogue_rows(acc, m0, n0, smem, [&](int m, int n, float4 a, float4 b) {
        if (m < NTOK) {
          a.x *= QSCALE; a.y *= QSCALE; a.z *= QSCALE; a.w *= QSCALE; b.x *= QSCALE; b.y *= QSCALE; b.z *= QSCALE; b.w *= QSCALE;
          *(uint4*)(AQ + (size_t)m * 1024 + n) = pack8(a, b);
        }
      });
    } else if (nt < 16) {
      epilogue_rows(acc, m0, n0, smem, [&](int m, int n, float4 a, float4 b) {
        if (m < NTOK) { int bb = m / LTOK, pos = m - bb * LTOK; *(uint4*)(AK + ((size_t)bb * LPAD + pos) * 1024 + (n - 1024)) = pack8(a, b); }
      });
    } else if (nt < 24) {
      epilogue_cols(acc, m0, n0, smem, [&](int m, int n, float4 a, float4 b) {
        if (m < NTOK) { int bb = m / LTOK, pos = m - bb * LTOK; *(uint4*)(AVT + ((size_t)(bb * 1024 + (n - 2048))) * LPAD + pos) = pack8(a, b); }
      });
    } else if (nt < 48) {
      epilogue_rows(acc, m0, n0, smem, [&](int m, int n, float4 a, float4 b) {
        if (m < NTOK) {
          int nn = n - 4096; int which = nn >> 10; int h = (nn >> 7) & 7; int d = nn & 127;
          int bb = m / LTOK, pos = m - bb * LTOK; int pp = pos + 48; int c = pp >> 6, rr = pp & 63;
          size_t blk = ((size_t)((bb * 8 + h) * NCH + c)) * 3 + which;
          uint4 o = pack8(a, b);
          *(uint4*)(DX + blk * 8192 + rr * 128 + d) = o;
          if (rr >= 61) *(uint4*)(HALO + blk * 384 + (rr - 61) * 128 + d) = o;
        }
      });
    } else {
      epilogue_rows(acc, m0, n0, smem, [&](int m, int n, float4 a, float4 b) {
        if (m < NTOK && n < 8208) {
          int isg = n >= 8200;
          int bb = m / LTOK, pos = m - bb * LTOK;
          float v[8] = {a.x, a.y, a.z, a.w, b.x, b.y, b.z, b.w};
#pragma unroll
          for (int h = 0; h < 8; ++h) {
            size_t o = (size_t)(bb * 8 + h) * LPAD + pos + 48;
            if (!isg) BETA[o] = sigmoidf_(v[h]);
            else { float z = v[h] + p.dt_bias[h]; float sp = z > 20.f ? z : log1pf(__expf(z)); GG[o] = -__expf(p.a_log[h]) * sp; }
          }
        }
      });
    }
  }
}

template <bool SIGNAL>
__device__ __forceinline__ void phase2(const Params& p, unsigned char* smem, const int lo, const int hi, const int worker, const int nworkers) {
  u16* DX = (u16*)(p.ws + OFF_DX); const u16* HALO = (const u16*)(p.ws + OFF_HALO);
  const float* BETA = (const float*)(p.ws + OFF_BETA); const float* GG = (const float*)(p.ws + OFF_G);
  u16* TA = (u16*)(p.ws + OFF_EXTRA);
  float* sin = (float*)smem;
  u16* sq = (u16*)(smem + 34304);
  u16* sk = sq + 64 * 136;
  u16* svT = sq;
  float* sgc = (float*)(smem + 34304 + 34816);
  float* sbeta = sgc + 64;
  float* sM = (float*)smem;
  const int tid = ltid(), lane = tid & 63, wave = tid >> 6;
  const int l31 = lane & 31, hf = lane >> 5;
  for (int idx2 = lo + worker; idx2 < hi; idx2 += nworkers) {
    const int bh = idx2 & 15, c = idx2 >> 4; const int it = bh * NCH + c; const int h = bh & 7;
    if (wave == 0) {
      const bool pad = (c == 0 && lane < 48);
      float g = pad ? 0.f : GG[(size_t)bh * LPAD + c * 64 + lane];
      float be = pad ? 0.f : BETA[(size_t)bh * LPAD + c * 64 + lane];
#pragma unroll
      for (int o = 1; o < 64; o <<= 1) { float t = __shfl_up(g, o); if (lane >= o) g += t; }
      sgc[lane] = g; sbeta[lane] = be;
    }
    for (int wi = 0; wi < 3; ++wi) {
      const int which = wi == 0 ? 2 : wi - 1;
      u16* X = DX + ((size_t)it * 3 + which) * 8192;
      const u16* H = HALO + ((size_t)(it - 1) * 3 + which) * 384;
      {
        u32x4 ld[5];
#pragma unroll
        for (int i = 0; i < 5; ++i) {
          const int idx = tid + 256 * i; const int rr = idx >> 4, c8 = (idx & 15) * 8; const int r = rr - 3;
          const bool zero = (idx >= 67 * 16) || (c == 0 && r < 48);
          const u16* srcp = (r < 0) ? (H + rr * 128 + c8) : (X + r * 128 + c8);
          u32x4 z = {0u, 0u, 0u, 0u};
          ld[i] = zero ? z : *(const u32x4*)srcp;
        }
#pragma unroll
        for (int i = 0; i < 5; ++i) {
          const int idx = tid + 256 * i; const int rr = idx >> 4, c8 = (idx & 15) * 8;
          if (idx < 67 * 16) {
            float4 a = make_float4(bflo(ld[i].x), bfhi(ld[i].x), bflo(ld[i].y), bfhi(ld[i].y));
            float4 b = make_float4(bflo(ld[i].z), bfhi(ld[i].z), bflo(ld[i].w), bfhi(ld[i].w));
            *(float4*)(sin + rr * 128 + c8) = a; *(float4*)(sin + rr * 128 + c8 + 4) = b;
          }
        }
      }
      __syncthreads();
      const int d0 = 2 * lane; const int ch = which * 1024 + h * 128 + d0;
      float w0[4], w1[4];
#pragma unroll
      for (int j = 0; j < 4; ++j) { w0[j] = p.conv_w[j * 3072 + ch]; w1[j] = p.conv_w[j * 3072 + ch + 1]; }
      for (int rb = 0; rb < 4; ++rb) {
        float y0[4], y1[4];
#pragma unroll
        for (int u = 0; u < 4; ++u) {
          const int r = wave * 16 + rb * 4 + u;
          float a0 = 0.f, a1 = 0.f;
#pragma unroll
          for (int j = 0; j < 4; ++j) { float2 xv = *(const float2*)(sin + (r + j) * 128 + d0); a0 += w0[j] * xv.x; a1 += w1[j] * xv.y; }
          y0[u] = siluf_(a0); y1[u] = siluf_(a1);
        }
        if (which < 2) {
          float ss[4];
#pragma unroll
          for (int u = 0; u < 4; ++u) ss[u] = y0[u] * y0[u] + y1[u] * y1[u];
#pragma unroll
          for (int o = 32; o > 0; o >>= 1) {
#pragma unroll
            for (int u = 0; u < 4; ++u) ss[u] += __shfl_xor(ss[u], o);
          }
#pragma unroll
          for (int u = 0; u < 4; ++u) {
            const int r = wave * 16 + rb * 4 + u;
            const bool pad = (c == 0 && r < 48);
            float sc = rsqrtf(ss[u] + 1e-6f) * (which == 0 ? 0.08838834764831845f : 1.f);
            if (pad) sc = 0.f;
            unsigned pk = cvtpk(y0[u] * sc, y1[u] * sc);
            *(unsigned*)(X + r * 128 + d0) = pk;
            *(unsigned*)((which == 0 ? sq : sk) + r * 136 + d0) = pk;
          }
        } else {
#pragma unroll
          for (int u = 0; u < 4; ++u) {
            const int r = wave * 16 + rb * 4 + u;
            const bool pad = (c == 0 && r < 48);
            float be = pad ? 0.f : sbeta[r];
            svT[d0 * 72 + r] = f2bf(y0[u] * be); svT[(d0 + 1) * 72 + r] = f2bf(y1[u] * be);
          }
        }
      }
      __syncthreads();
      if (which == 2) {
#pragma unroll
        for (int i = 0; i < 4; ++i) { int idx = tid + 256 * i; int e = idx >> 3, c8 = (idx & 7) * 8; *(uint4*)(X + e * 64 + c8) = *(const uint4*)(svT + e * 72 + c8); }
      }
    }
    const int ti = wave >> 1, tj = wave & 1;
    f32x16 kk, qk;
#pragma unroll
    for (int r = 0; r < 16; ++r) { kk[r] = 0.f; qk[r] = 0.f; }
#pragma unroll
    for (int s = 0; s < 8; ++s) {
      bf16x8 bj = *(const bf16x8*)(sk + (32 * tj + l31) * 136 + s * 16 + hf * 8);
      bf16x8 ak = *(const bf16x8*)(sk + (32 * ti + l31) * 136 + s * 16 + hf * 8);
      bf16x8 aq = *(const bf16x8*)(sq + (32 * ti + l31) * 136 + s * 16 + hf * 8);
      kk = mfma32(ak, bj, kk); qk = mfma32(aq, bj, qk);
    }
    __syncthreads();
    u16* Tg = TA + (size_t)it * 8704; u16* Ag = Tg + 4096; float* SCg = (float*)(Tg + 8192);
    {
      const int j = 32 * tj + l31; const float gcj = sgc[j];
#pragma unroll
      for (int r = 0; r < 16; ++r) {
        const int i = 32 * ti + 8 * (r >> 2) + 4 * hf + (r & 3);
        const float gci = sgc[i]; const float bi = sbeta[i];
        const float dec = __expf(gci - gcj);
        sM[i * 68 + j] = (j < i) ? bi * kk[r] * dec : 0.f;
        Ag[i * 64 + j] = f2bf((j <= i) ? qk[r] * dec : 0.f);
      }
    }
    __syncthreads();
    float* sTc = (float*)sq;
    if (wave == 0) {
      float* mycol = sTc + lane * 68;
#pragma unroll 1
      for (int blk = 0; blk < 4; ++blk) {
        const int r0 = blk * 16;
        float acc[16];
#pragma unroll
        for (int r = 0; r < 16; ++r) acc[r] = 0.f;
#pragma unroll 1
        for (int j = 0; j < r0; j += 4) {
          const float4 t4 = *(const float4*)(mycol + j);
#pragma unroll
          for (int r = 0; r < 16; ++r) {
            const float4 m4 = *(const float4*)(sM + (r0 + r) * 68 + j);
            acc[r] += (m4.x * t4.x + m4.y * t4.y) + (m4.z * t4.z + m4.w * t4.w);
          }
        }
        float tt[16];
#pragma unroll
        for (int r = 0; r < 16; ++r) {
          float s = acc[r];
#pragma unroll
          for (int q4 = 0; q4 < r; q4 += 4) {
            const float4 m4 = *(const float4*)(sM + (r0 + r) * 68 + r0 + q4);
            s += m4.x * tt[q4];
            if (q4 + 1 < r) s += m4.y * tt[q4 + 1];
            if (q4 + 2 < r) s += m4.z * tt[q4 + 2];
            if (q4 + 3 < r) s += m4.w * tt[q4 + 3];
          }
          tt[r] = ((r0 + r == lane) ? 1.f : 0.f) - s;
        }
#pragma unroll
        for (int r = 0; r < 16; r += 4) *(float4*)(mycol + r0 + r) = make_float4(tt[r], tt[r + 1], tt[r + 2], tt[r + 3]);
      }
    }
    __syncthreads();
#pragma unroll
    for (int i = 0; i < 2; ++i) {
      int idx = tid + 256 * i; int r = idx >> 3, c8 = (idx & 7) * 8; const float* s = sTc + c8 * 68 + r;
      uint4 o; o.x = cvtpk(s[0], s[68]); o.y = cvtpk(s[136], s[204]); o.z = cvtpk(s[272], s[340]); o.w = cvtpk(s[408], s[476]);
      *(uint4*)(Tg + r * 64 + c8) = o;
    }
    if (tid < 64) {
      float gc = sgc[tid], be = sbeta[tid]; float eg = __expf(gc);
      SCg[tid] = be; SCg[64 + tid] = be * eg; SCg[128 + tid] = eg; SCg[192 + tid] = __expf(sgc[63] - gc);
    }
    __syncthreads();
    if (SIGNAL && tid == 0)
      __hip_atomic_fetch_add((unsigned*)(p.ws + OFF_BAR) + 16 + bh * 17 + (c >> 3), 1u, __ATOMIC_RELEASE, __HIP_MEMORY_SCOPE_AGENT);
  }
}

__device__ __forceinline__ bf16x8 mk8(uint2 lo, uint2 hi) { u32x4 t = {lo.x, lo.y, hi.x, hi.y}; return __builtin_bit_cast(bf16x8, t); }

__device__ __forceinline__ void scan_chunked(const Params& p, unsigned char* smem, int bh, f32x16 (&S)[4], const int c_begin, const int c_end) {
  u16* DX = (u16*)(p.ws + OFF_DX); const u16* TA = (const u16*)(p.ws + OFF_EXTRA);
  const int tid = ltid(), lane = tid & 63, wave = tid >> 6;
  const int l31 = lane & 31, hf = lane >> 5;
  u16* sk = (u16*)smem;
  u16* sq = sk + 64 * 136;
  u16* sT = sq + 64 * 136;
  u16* sA = sT + 64 * 72;
  float* sSC = (float*)(sA + 64 * 72);
  u32x4 pk[4], pq[4], pT[2], pA[2]; uint2 pv[8]; float psc;
#pragma unroll 1
  for (int c = c_begin; c < c_end; ++c) {
    if (c >= P2_SPLIT && (c & 7) == 0) {
      const unsigned need = (c == 128) ? 1u : 8u;
      if (tid == 0) {
        const unsigned* f = (const unsigned*)(p.ws + OFF_BAR) + 16 + bh * 17 + (c >> 3);
        while (__hip_atomic_load(f, __ATOMIC_RELAXED, __HIP_MEMORY_SCOPE_AGENT) < need) __builtin_amdgcn_s_sleep(2);
        __builtin_amdgcn_fence(__ATOMIC_ACQUIRE, "agent");
      }
      __syncthreads();
    }
    {
      const u16* Xq = DX + ((size_t)(bh * NCH + c) * 3) * 8192; const u16* Xk = Xq + 8192; const u16* Xv = Xk + 8192;
      const u16* Tg = TA + (size_t)(bh * NCH + c) * 8704; const u16* Ag = Tg + 4096;
#pragma unroll
      for (int i = 0; i < 4; ++i) { pk[i] = *(const u32x4*)(Xk + (tid + 256 * i) * 8); pq[i] = *(const u32x4*)(Xq + (tid + 256 * i) * 8); }
#pragma unroll
      for (int i = 0; i < 2; ++i) { pT[i] = *(const u32x4*)(Tg + (tid + 256 * i) * 8); pA[i] = *(const u32x4*)(Ag + (tid + 256 * i) * 8); }
      psc = ((const float*)(Tg + 8192))[tid];
#pragma unroll
      for (int i = 0; i < 8; ++i) pv[i] = *(const uint2*)(Xv + (wave * 32 + l31) * 64 + 32 * (i >> 2) + 8 * (i & 3) + 4 * hf);
    }
#pragma unroll
    for (int i = 0; i < 4; ++i) {
      int idx = tid + 256 * i; int row = idx >> 4, ch = idx & 15; const int po = (ch >> 1) * 16 + (ch & 1) * 4;
      u16* dk = sk + row * 136 + po; *(uint2*)dk = make_uint2(pk[i].x, pk[i].y); *(uint2*)(dk + 8) = make_uint2(pk[i].z, pk[i].w);
      u16* dq = sq + row * 136 + po; *(uint2*)dq = make_uint2(pq[i].x, pq[i].y); *(uint2*)(dq + 8) = make_uint2(pq[i].z, pq[i].w);
    }
#pragma unroll
    for (int i = 0; i < 2; ++i) {
      int idx = tid + 256 * i; int row = idx >> 3, ch = idx & 7; const int po = (ch >> 1) * 16 + (ch & 1) * 4;
      u16* dt = sT + row * 72 + po; *(uint2*)dt = make_uint2(pT[i].x, pT[i].y); *(uint2*)(dt + 8) = make_uint2(pT[i].z, pT[i].w);
      u16* da = sA + row * 72 + po; *(uint2*)da = make_uint2(pA[i].x, pA[i].y); *(uint2*)(da + 8) = make_uint2(pA[i].z, pA[i].w);
    }
    sSC[tid] = psc;
    lds_barrier();
    __builtin_amdgcn_sched_barrier(0);
    u32x4 yf[4];
    {
      f32x16 x0, x1;
#pragma unroll
      for (int r = 0; r < 16; ++r) { x0[r] = 0.f; x1[r] = 0.f; }
#pragma unroll
      for (int dt = 0; dt < 4; ++dt)
#pragma unroll
        for (int s = 0; s < 2; ++s) {
          u32x4 sb = {cvtpk(S[dt][8 * s + 0], S[dt][8 * s + 1]), cvtpk(S[dt][8 * s + 2], S[dt][8 * s + 3]), cvtpk(S[dt][8 * s + 4], S[dt][8 * s + 5]), cvtpk(S[dt][8 * s + 6], S[dt][8 * s + 7])};
          const bf16x8 k0f = *(const bf16x8*)(sk + (l31) * 136 + 32 * dt + 16 * s + 8 * hf);
          const bf16x8 k1f = *(const bf16x8*)(sk + (32 + l31) * 136 + 32 * dt + 16 * s + 8 * hf);
          x0 = mfma32(k0f, __builtin_bit_cast(bf16x8, sb), x0);
          x1 = mfma32(k1f, __builtin_bit_cast(bf16x8, sb), x1);
        }
#pragma unroll
      for (int g = 0; g < 4; ++g) {
        {
          float4 bg4 = *(const float4*)(sSC + 64 + 8 * g + 4 * hf);
          uint2 vb = pv[g];
          yf[(g >> 1)][(g & 1) * 2 + 0] = cvtpk(bflo(vb.x) - bg4.x * x0[4 * g + 0], bfhi(vb.x) - bg4.y * x0[4 * g + 1]);
          yf[(g >> 1)][(g & 1) * 2 + 1] = cvtpk(bflo(vb.y) - bg4.z * x0[4 * g + 2], bfhi(vb.y) - bg4.w * x0[4 * g + 3]);
        }
        {
          float4 bg4 = *(const float4*)(sSC + 64 + 32 + 8 * g + 4 * hf);
          uint2 vb = pv[4 + g];
          yf[2 + (g >> 1)][(g & 1) * 2 + 0] = cvtpk(bflo(vb.x) - bg4.x * x1[4 * g + 0], bfhi(vb.x) - bg4.y * x1[4 * g + 1]);
          yf[2 + (g >> 1)][(g & 1) * 2 + 1] = cvtpk(bflo(vb.y) - bg4.z * x1[4 * g + 2], bfhi(vb.y) - bg4.w * x1[4 * g + 3]);
        }
      }
    }
    __builtin_amdgcn_sched_barrier(0);
    u32x4 vnf[4];
    {
      f32x16 v0, v1;
#pragma unroll
      for (int r = 0; r < 16; ++r) { v0[r] = 0.f; v1[r] = 0.f; }
#pragma unroll
      for (int s = 0; s < 4; ++s) {
        const bf16x8 t0f = *(const bf16x8*)(sT + (l31) * 72 + 16 * s + 8 * hf);
        const bf16x8 t1f = *(const bf16x8*)(sT + (32 + l31) * 72 + 16 * s + 8 * hf);
        v0 = mfma32(t0f, __builtin_bit_cast(bf16x8, yf[s]), v0);
        v1 = mfma32(t1f, __builtin_bit_cast(bf16x8, yf[s]), v1);
      }
#pragma unroll
      for (int g = 0; g < 4; ++g) {
        vnf[(g >> 1)][(g & 1) * 2 + 0] = cvtpk(v0[4 * g + 0], v0[4 * g + 1]);
        vnf[(g >> 1)][(g & 1) * 2 + 1] = cvtpk(v0[4 * g + 2], v0[4 * g + 3]);
        vnf[2 + (g >> 1)][(g & 1) * 2 + 0] = cvtpk(v1[4 * g + 0], v1[4 * g + 1]);
        vnf[2 + (g >> 1)][(g & 1) * 2 + 1] = cvtpk(v1[4 * g + 2], v1[4 * g + 3]);
      }
    }
    __builtin_amdgcn_sched_barrier(0);
    u16* Oq = DX + ((size_t)(bh * NCH + c) * 3) * 8192;
    {
      f32x16 o0, o1;
#pragma unroll
      for (int r = 0; r < 16; ++r) { o0[r] = 0.f; o1[r] = 0.f; }
#pragma unroll
      for (int dt = 0; dt < 4; ++dt)
#pragma unroll
        for (int s = 0; s < 2; ++s) {
          u32x4 sb = {cvtpk(S[dt][8 * s + 0], S[dt][8 * s + 1]), cvtpk(S[dt][8 * s + 2], S[dt][8 * s + 3]), cvtpk(S[dt][8 * s + 4], S[dt][8 * s + 5]), cvtpk(S[dt][8 * s + 6], S[dt][8 * s + 7])};
          const bf16x8 q0f = *(const bf16x8*)(sq + (l31) * 136 + 32 * dt + 16 * s + 8 * hf);
          const bf16x8 q1f = *(const bf16x8*)(sq + (32 + l31) * 136 + 32 * dt + 16 * s + 8 * hf);
          o0 = mfma32(q0f, __builtin_bit_cast(bf16x8, sb), o0);
          o1 = mfma32(q1f, __builtin_bit_cast(bf16x8, sb), o1);
        }
#pragma unroll
      for (int g = 0; g < 4; ++g) {
        float4 e0 = *(const float4*)(sSC + 128 + 8 * g + 4 * hf), e1 = *(const float4*)(sSC + 128 + 32 + 8 * g + 4 * hf);
        o0[4 * g + 0] *= e0.x; o0[4 * g + 1] *= e0.y; o0[4 * g + 2] *= e0.z; o0[4 * g + 3] *= e0.w;
        o1[4 * g + 0] *= e1.x; o1[4 * g + 1] *= e1.y; o1[4 * g + 2] *= e1.z; o1[4 * g + 3] *= e1.w;
      }
#pragma unroll
      for (int s = 0; s < 4; ++s) {
        const bf16x8 a0f = *(const bf16x8*)(sA + (l31) * 72 + 16 * s + 8 * hf);
        const bf16x8 a1f = *(const bf16x8*)(sA + (32 + l31) * 72 + 16 * s + 8 * hf);
        o0 = mfma32(a0f, __builtin_bit_cast(bf16x8, vnf[s]), o0);
        o1 = mfma32(a1f, __builtin_bit_cast(bf16x8, vnf[s]), o1);
      }
#pragma unroll
      for (int r = 0; r < 16; ++r) {
        Oq[(8 * (r >> 2) + 4 * hf + (r & 3)) * 128 + wave * 32 + l31] = f2bf(o0[r]);
        Oq[(32 + 8 * (r >> 2) + 4 * hf + (r & 3)) * 128 + wave * 32 + l31] = f2bf(o1[r]);
      }
    }
    __builtin_amdgcn_sched_barrier(0);
    const float cd = sSC[128 + 63];
#pragma unroll
    for (int dt = 0; dt < 4; ++dt)
#pragma unroll
      for (int r = 0; r < 16; ++r) S[dt][r] *= cd;
    u32x4 vs[4];
#pragma unroll
    for (int s = 0; s < 4; ++s) {
      const float4 e0 = *(const float4*)(sSC + 192 + 16 * s + 4 * hf), e1 = *(const float4*)(sSC + 192 + 16 * s + 8 + 4 * hf);
      vs[s].x = cvtpk(bflo(vnf[s].x) * e0.x, bfhi(vnf[s].x) * e0.y); vs[s].y = cvtpk(bflo(vnf[s].y) * e0.z, bfhi(vnf[s].y) * e0.w);
      vs[s].z = cvtpk(bflo(vnf[s].z) * e1.x, bfhi(vnf[s].z) * e1.y); vs[s].w = cvtpk(bflo(vnf[s].w) * e1.z, bfhi(vnf[s].w) * e1.w);
    }
    {
      u32x4 id1 = {0u, 0u, 0u, 0u}, id2 = {0u, 0u, 0u, 0u};
      {
        const int l15 = l31 & 15;
        const int jsel = (((l15 >> 2) & 1) == hf) ? (4 * (l15 >> 3) + (l15 & 3)) : -1;
        const int j1 = (l31 < 16) ? jsel : -1;
        const int j2 = (l31 >= 16) ? jsel : -1;
        const unsigned one_lo = 0x3f80u, one_hi = 0x3f800000u;
#pragma unroll
        for (int w = 0; w < 4; ++w) {
          id1[w] = (j1 == 2 * w) ? one_lo : ((j1 == 2 * w + 1) ? one_hi : 0u);
          id2[w] = (j2 == 2 * w) ? one_lo : ((j2 == 2 * w + 1) ? one_hi : 0u);
        }
      }
      const bf16x8 B1 = __builtin_bit_cast(bf16x8, id1), B2 = __builtin_bit_cast(bf16x8, id2);
#pragma unroll
      for (int dt = 0; dt < 4; ++dt)
#pragma unroll
        for (int mt = 0; mt < 2; ++mt) {
          f32x16 kt;
#pragma unroll
          for (int r = 0; r < 16; ++r) kt[r] = 0.f;
          const u16* k0 = sk + (32 * mt + l31) * 136 + 32 * dt + 8 * hf;
          kt = mfma32(*(const bf16x8*)(k0), B1, kt);
          kt = mfma32(*(const bf16x8*)(k0 + 16), B2, kt);
#pragma unroll
          for (int s2 = 0; s2 < 2; ++s2) {
            u32x4 af = {cvtpk(kt[8 * s2 + 0], kt[8 * s2 + 1]), cvtpk(kt[8 * s2 + 2], kt[8 * s2 + 3]), cvtpk(kt[8 * s2 + 4], kt[8 * s2 + 5]), cvtpk(kt[8 * s2 + 6], kt[8 * s2 + 7])};
            S[dt] = mfma32(__builtin_bit_cast(bf16x8, af), __builtin_bit_cast(bf16x8, vs[2 * mt + s2]), S[dt]);
          }
        }
    }
    lds_barrier();
  }
}

__device__ __forceinline__ void attn_item(const Params& p, unsigned char* smem, int b, int h, int qb, float lam) {
  int tid_ = ltid();
  const int tid = tid_, lane = tid & 63, wave = tid >> 6;
  const int l31 = lane & 31, hf = lane >> 5;
  const int map = wave >> 1, r0 = (wave & 1) * 32;
  u16* AQ = (u16*)(p.ws + OFF_AQ); const u16* AK = (const u16*)(p.ws + OFF_AK); const u16* AVT = (const u16*)(p.ws + OFF_AVT);
  u16* sK = (u16*)smem;
  float* sO = (float*)smem;
  const int t0 = qb * 64; const int ntiles = qb + 2;
  const size_t qrow = (size_t)(b * LTOK + NMETA + t0 + r0 + l31);
  bf16x8 qf[4];
#pragma unroll
  for (int s = 0; s < 4; ++s) qf[s] = *(const bf16x8*)(AQ + qrow * 1024 + h * 128 + map * 64 + s * 16 + hf * 8);
  f32x16 oacc[4];
#pragma unroll
  for (int d = 0; d < 4; ++d)
#pragma unroll
    for (int r = 0; r < 16; ++r) oacc[d][r] = 0.f;
  float m_run = -1e30f, l_run = 0.f;
  const int qpos = NMETA + t0 + r0 + l31;
  const u16* kbase = AK + ((size_t)b * LPAD) * 1024 + h * 128;
  const u16* vbase = AVT + ((size_t)(b * 8 + h) * 128) * LPAD;
  const int kc = tid & 15, kr = tid >> 4;
  const int vc = tid & 7, vr = tid >> 3;
  u32x4 ak[4], av[4], bk[4], bv[4];
  auto gload = [&](u32x4 (&rk)[4], u32x4 (&rv)[4], int kt) {
#pragma unroll
    for (int i = 0; i < 4; ++i) {
      rk[i] = *(const u32x4*)(kbase + (size_t)(kt * 64 + kr + 16 * i) * 1024 + kc * 8);
      rv[i] = *(const u32x4*)(vbase + (size_t)(vr + 32 * i) * LPAD + kt * 64 + vc * 8);
    }
  };
  auto swrite = [&](const u32x4 (&rk)[4], const u32x4 (&rv)[4], int buf) {
    u16* bK = sK + buf * 17920; u16* bV = bK + 64 * 136;
#pragma unroll
    for (int i = 0; i < 4; ++i) {
      *(u32x4*)(bK + (kr + 16 * i) * 136 + kc * 8) = rk[i];
      u16* dst = bV + (vr + 32 * i) * 72 + (vc >> 1) * 16 + (vc & 1) * 4;
      *(uint2*)dst = make_uint2(rv[i].x, rv[i].y); *(uint2*)(dst + 8) = make_uint2(rv[i].z, rv[i].w);
    }
  };
  auto compute = [&](int kt, int buf) {
    const u16* bK = sK + buf * 17920; const u16* bV = bK + 64 * 136;
    __builtin_amdgcn_s_setprio(1);
    f32x16 st[2];
#pragma unroll
    for (int mt = 0; mt < 2; ++mt) {
#pragma unroll
      for (int r = 0; r < 16; ++r) st[mt][r] = 0.f;
#pragma unroll
      for (int s = 0; s < 4; ++s) {
        bf16x8 kf = *(const bf16x8*)(bK + (mt * 32 + l31) * 136 + map * 64 + s * 16 + hf * 8);
        st[mt] = mfma32(kf, qf[s], st[mt]);
      }
    }
    __builtin_amdgcn_s_setprio(0);
    if (kt >= ntiles - 2) {
#pragma unroll
      for (int mt = 0; mt < 2; ++mt)
#pragma unroll
        for (int r = 0; r < 16; ++r) {
          int key = kt * 64 + mt * 32 + 8 * (r >> 2) + 4 * hf + (r & 3);
          if (key > qpos) st[mt][r] = -1e30f;
        }
    }
    float mx = -1e30f;
#pragma unroll
    for (int mt = 0; mt < 2; ++mt)
#pragma unroll
      for (int r = 0; r < 16; ++r) mx = fmaxf(mx, st[mt][r]);
    mx = fmaxf(mx, __shfl_xor(mx, 32));
    const float m_new = fmaxf(m_run, mx);
    const float alpha = __builtin_amdgcn_exp2f(m_run - m_new);
    float rsum = 0.f;
#pragma unroll
    for (int mt = 0; mt < 2; ++mt)
#pragma unroll
      for (int r = 0; r < 16; ++r) { float pv = __builtin_amdgcn_exp2f(st[mt][r] - m_new); st[mt][r] = pv; rsum += pv; }
    l_run = l_run * alpha + rsum; m_run = m_new;
#pragma unroll
    for (int d = 0; d < 4; ++d)
#pragma unroll
      for (int r = 0; r < 16; ++r) oacc[d][r] *= alpha;
    __builtin_amdgcn_s_setprio(1);
#pragma unroll
    for (int s = 0; s < 4; ++s) {
      const int mt = s >> 1, ss = s & 1;
      u32x4 pt = {cvtpk(st[mt][8 * ss + 0], st[mt][8 * ss + 1]), cvtpk(st[mt][8 * ss + 2], st[mt][8 * ss + 3]),
                  cvtpk(st[mt][8 * ss + 4], st[mt][8 * ss + 5]), cvtpk(st[mt][8 * ss + 6], st[mt][8 * ss + 7])};
      bf16x8 pf = __builtin_bit_cast(bf16x8, pt);
#pragma unroll
      for (int d = 0; d < 4; ++d) {
        const bf16x8 vf = *(const bf16x8*)(bV + (d * 32 + l31) * 72 + mt * 32 + ss * 16 + hf * 8);
        oacc[d] = mfma32(vf, pf, oacc[d]);
      }
    }
    __builtin_amdgcn_s_setprio(0);
  };
  gload(ak, av, 0); swrite(ak, av, 0); gload(bk, bv, 1);
  lds_barrier();
#pragma unroll 1
  for (int kt = 0; kt < ntiles; kt += 2) {
    if (kt + 2 < ntiles) gload(ak, av, kt + 2);
    compute(kt, 0);
    if (kt + 1 < ntiles) swrite(bk, bv, 1);
    lds_barrier();
    if (kt + 1 < ntiles) {
      if (kt + 3 < ntiles) gload(bk, bv, kt + 3);
      compute(kt + 1, 1);
      if (kt + 2 < ntiles) swrite(ak, av, 0);
      lds_barrier();
    }
  }
  const float l_tot = l_run + __shfl_xor(l_run, 32);
  const float inv = 1.f / l_tot;
#pragma unroll
  for (int d = 0; d < 4; ++d)
#pragma unroll
    for (int g = 0; g < 4; ++g) {
      float4 o4 = make_float4(oacc[d][4 * g] * inv, oacc[d][4 * g + 1] * inv, oacc[d][4 * g + 2] * inv, oacc[d][4 * g + 3] * inv);
      *(float4*)(sO + ((map * 64 + r0 + l31) * 132 + d * 32 + 8 * g + 4 * hf)) = o4;
    }
  __syncthreads();
  {
    const int q = tid >> 2, qq = tid & 3;
    const float4* o0 = (const float4*)(sO + (q * 132 + qq * 32)); const float4* o1 = (const float4*)(sO + ((64 + q) * 132 + qq * 32));
    float ss = 0.f;
#pragma unroll
    for (int i = 0; i < 8; ++i) {
      float4 a = o0[i], c = o1[i];
      float dx = a.x - lam * c.x, dy = a.y - lam * c.y, dz = a.z - lam * c.z, dw = a.w - lam * c.w;
      ss += dx * dx + dy * dy + dz * dz + dw * dw;
    }
    ss += __shfl_xor(ss, 1); ss += __shfl_xor(ss, 2);
    const float rsn = rsqrtf(ss * (1.f / 128.f) + 1e-6f) * 0.8f;
    const float4* nw = (const float4*)(p.attn_norm_w + qq * 32);
    uint4* dst = (uint4*)(AQ + (size_t)(b * LTOK + NMETA + t0 + q) * 1024 + h * 128 + qq * 32);
#pragma unroll
    for (int i = 0; i < 4; ++i) {
      float4 a0 = o0[2 * i], c0 = o1[2 * i], a1 = o0[2 * i + 1], c1 = o1[2 * i + 1];
      float4 w0 = nw[2 * i], w1 = nw[2 * i + 1];
      uint4 o;
      o.x = cvtpk((a0.x - lam * c0.x) * rsn * w0.x, (a0.y - lam * c0.y) * rsn * w0.y);
      o.y = cvtpk((a0.z - lam * c0.z) * rsn * w0.z, (a0.w - lam * c0.w) * rsn * w0.w);
      o.z = cvtpk((a1.x - lam * c1.x) * rsn * w1.x, (a1.y - lam * c1.y) * rsn * w1.y);
      o.w = cvtpk((a1.z - lam * c1.z) * rsn * w1.z, (a1.w - lam * c1.w) * rsn * w1.w);
      dst[i] = o;
    }
  }
  __syncthreads();
}

__device__ __forceinline__ void phase3(const Params& p, unsigned char* smem, unsigned* bar) {
  __shared__ int s_item;
  const int tid = ltid();
  const bool is_scan = (blockIdx.x < 16);
  if (is_scan) {
    f32x16 S[4];
#pragma unroll
    for (int d = 0; d < 4; ++d)
#pragma unroll
      for (int r = 0; r < 16; ++r) S[d][r] = 0.f;
    __builtin_amdgcn_s_setprio(2);
    scan_chunked(p, smem, blockIdx.x, S, 0, NCH);
    __builtin_amdgcn_s_setprio(0);
  } else {
    phase2<true>(p, smem, P2_SPLIT * 16, NCH * 16, blockIdx.x - 16, gridDim.x - 16);
  }
  int* cnt = (int*)(p.ws + OFF_CTL);
  const float lam = ((const float*)(p.ws + OFF_CTL))[16];
  const int myq = blockIdx.x & 7;
  for (int qq = 0; qq < 8; ++qq) {
    const int q = (myq + qq) & 7;
    while (true) {
      if (tid == 0) s_item = atomicAdd(&cnt[q], 1);
      __syncthreads();
      const int idx = s_item;
      __syncthreads();
      if (idx >= 256) break;
      attn_item(p, smem, idx & 1, q, 127 - (idx >> 1), lam);
    }
  }
}

__device__ __forceinline__ int tokrow_of(int m) { int b = m >> 13; return b * LTOK + NMETA + (m & 8191); }

__device__ __forceinline__ void phase4(const Params& p, unsigned char* smem) {
  const u16* hn = (const u16*)p.out; const u16* wtin = hn + (size_t)NTOK * DM;
  u16* AQ = (u16*)(p.ws + OFF_AQ); u16* DX = (u16*)(p.ws + OFF_DX);
  u16* SGA = (u16*)(p.ws + OFF_AK); u16* SGD = (u16*)(p.ws + OFF_AVT);
  const int xcd = blockIdx.x & 7, lw = blockIdx.x >> 3, LW = (gridDim.x - xcd + 7) >> 3;
  for (int i = lw;; i += LW) {
    int mt, nt; if (!tile_map(i, xcd, 128, 32, mt, nt)) break;
    const int m0 = mt * 128;
    const int n0 = nt < 8 ? 3072 + nt * 128 : (nt < 16 ? 7168 + (nt - 8) * 128 : 8208 + (nt - 16) * 128);
    f32x16 acc[2][2]; zero_acc(acc);
    gemm_kloop(acc, [&](int m) { return hn + (size_t)tokrow_of(m) * DM; }, [](int k0) { return (size_t)k0; }, wtin, m0, n0, smem);
    if (nt < 8) {
      epilogue_rows(acc, m0, n0, smem, [&](int m, int n, float4 a, float4 b) {
        uint4* ptr = (uint4*)(AQ + (size_t)tokrow_of(m) * 1024 + (n - 3072));
        uint4 o = *ptr;
        a.x = bflo(o.x) * siluf_(a.x); a.y = bfhi(o.x) * siluf_(a.y); a.z = bflo(o.y) * siluf_(a.z); a.w = bfhi(o.y) * siluf_(a.w);
        b.x = bflo(o.z) * siluf_(b.x); b.y = bfhi(o.z) * siluf_(b.y); b.z = bflo(o.w) * siluf_(b.z); b.w = bfhi(o.w) * siluf_(b.w);
        *ptr = pack8(a, b);
      });
    } else if (nt < 16) {
      epilogue_rows(acc, m0, n0, smem, [&](int m, int n, float4 a, float4 b) {
        int col = n - 7168; int h = col >> 7, d = col & 127;
        int bb = m >> 13, t = m & 8191; int bh = bb * 8 + h; int pp = t + 64;
        uint4* ptr = (uint4*)(DX + (((size_t)(bh * NCH + (pp >> 6))) * 3) * 8192 + (pp & 63) * 128 + d);
        uint4 o = *ptr;
        float o0 = bflo(o.x), o1 = bfhi(o.x), o2 = bflo(o.y), o3 = bfhi(o.y), o4 = bflo(o.z), o5 = bfhi(o.z), o6 = bflo(o.w), o7 = bfhi(o.w);
        float sq = o0 * o0 + o1 * o1 + o2 * o2 + o3 * o3 + o4 * o4 + o5 * o5 + o6 * o6 + o7 * o7;
        sq += __shfl_xor(sq, 1); sq += __shfl_xor(sq, 2); sq += __shfl_xor(sq, 4); sq += __shfl_xor(sq, 8);
        float rs = rsqrtf(sq * (1.f / 128.f) + 1e-6f);
        float4 w0 = *(const float4*)(p.dn_norm_w + d), w1 = *(const float4*)(p.dn_norm_w + d + 4);
        a.x = o0 * rs * w0.x * siluf_(a.x); a.y = o1 * rs * w0.y * siluf_(a.y); a.z = o2 * rs * w0.z * siluf_(a.z); a.w = o3 * rs * w0.w * siluf_(a.w);
        b.x = o4 * rs * w1.x * siluf_(b.x); b.y = o5 * rs * w1.y * siluf_(b.y); b.z = o6 * rs * w1.z * siluf_(b.z); b.w = o7 * rs * w1.w * siluf_(b.w);
        *ptr = pack8(a, b);
      });
    } else {
      epilogue_rows(acc, m0, n0, smem, [&](int m, int n, float4 a, float4 b) {
        int col = n - 8208; u16* dst = col < 1024 ? SGA + col : SGD + (col - 1024);
        a.x = sigmoidf_(a.x); a.y = sigmoidf_(a.y); a.z = sigmoidf_(a.z); a.w = sigmoidf_(a.w);
        b.x = sigmoidf_(b.x); b.y = sigmoidf_(b.y); b.z = sigmoidf_(b.z); b.w = sigmoidf_(b.w);
        *(uint4*)(dst + (size_t)m * 1024) = pack8(a, b);
      });
    }
  }
}

__device__ __forceinline__ void phase5(const Params& p, unsigned char* smem) {
  const u16* AQ = (const u16*)(p.ws + OFF_AQ); const u16* DX = (const u16*)(p.ws + OFF_DX);
  const u16* SGA = (const u16*)(p.ws + OFF_AK); const u16* SGD = (const u16*)(p.ws + OFF_AVT);
  const u16* wat = (const u16*)(p.ws + OFF_W3); const u16* wdt = wat + 1024 * 1024;
  u16* MERGED = (u16*)(p.ws + OFF_EXTRA);
  const int xcd = blockIdx.x & 7, lw = blockIdx.x >> 3, LW = (gridDim.x - xcd + 7) >> 3;
  for (int i = lw;; i += LW) {
    int mt, nt; if (!tile_map(i, xcd, 128, 8, mt, nt)) break;
    const int m0 = mt * 128, n0 = nt * 128;
    f32x16 acc[2][2]; zero_acc(acc);
    gemm_kloop(acc, [&](int m) { return AQ + (size_t)tokrow_of(m) * 1024; }, [](int k0) { return (size_t)k0; }, wat, m0, n0, smem);
    epilogue_rows(acc, m0, n0, smem, [&](int m, int n, float4 a, float4 b) {
      uint4 g = *(const uint4*)(SGA + (size_t)m * 1024 + n);
      a.x *= bflo(g.x); a.y *= bfhi(g.x); a.z *= bflo(g.y); a.w *= bfhi(g.y); b.x *= bflo(g.z); b.y *= bfhi(g.z); b.z *= bflo(g.w); b.w *= bfhi(g.w);
      *(uint4*)(MERGED + (size_t)m * 1024 + n) = pack8(a, b);
    });
  }
  for (int i = lw;; i += LW) {
    int mt, nt; if (!tile_map(i, xcd, 128, 8, mt, nt)) break;
    const int m0 = mt * 128, n0 = nt * 128;
    f32x16 acc[2][2]; zero_acc(acc);
    gemm_kloop(acc, [&](int m) {
      int bb = m >> 13, t = m & 8191; int pp = t + 64;
      return DX + (((size_t)((bb * 8) * NCH + (pp >> 6))) * 3) * 8192 + (pp & 63) * 128;
    }, [](int k0) { return (size_t)(k0 >> 7) * ((size_t)NCH * 3 * 8192) + (size_t)(k0 & 127); }, wdt, m0, n0, smem);
    epilogue_rows(acc, m0, n0, smem, [&](int m, int n, float4 a, float4 b) {
      uint4 g = *(const uint4*)(SGD + (size_t)m * 1024 + n);
      uint4* ptr = (uint4*)(MERGED + (size_t)m * 1024 + n);
      uint4 o = *ptr;
      a.x = bflo(o.x) + a.x * bflo(g.x); a.y = bfhi(o.x) + a.y * bfhi(g.x); a.z = bflo(o.y) + a.z * bflo(g.y); a.w = bfhi(o.y) + a.w * bfhi(g.y);
      b.x = bflo(o.z) + b.x * bflo(g.z); b.y = bfhi(o.z) + b.y * bfhi(g.z); b.z = bflo(o.w) + b.z * bflo(g.w); b.w = bfhi(o.w) + b.w * bfhi(g.w);
      *ptr = pack8(a, b);
    });
  }
}

__device__ __forceinline__ void phase6(const Params& p, unsigned char* smem) {
  const u16* MERGED = (const u16*)(p.ws + OFF_EXTRA);
  const u16* wot = (const u16*)(p.ws + OFF_W3) + 2 * 1024 * 1024;
  float* PSUM = (float*)(p.ws + OFF_PSUM);
  const int xcd = blockIdx.x & 7, lw = blockIdx.x >> 3, LW = (gridDim.x - xcd + 7) >> 3;
  for (int i = lw;; i += LW) {
    int mt, nt; if (!tile_map(i, xcd, 128, 8, mt, nt)) break;
    const int m0 = mt * 128, n0 = nt * 128;
    f32x16 acc[2][2]; zero_acc(acc);
    gemm_kloop(acc, [&](int m) { return MERGED + (size_t)m * 1024; }, [](int k0) { return (size_t)k0; }, wot, m0, n0, smem);
    epilogue_rows(acc, m0, n0, smem, [&](int m, int n, float4 a, float4 b) {
      const float4* xp = (const float4*)(p.x + (size_t)m * 1024 + n);
      float4 x0 = xp[0], x1 = xp[1];
      a.x += x0.x; a.y += x0.y; a.z += x0.z; a.w += x0.w; b.x += x1.x; b.y += x1.y; b.z += x1.z; b.w += x1.w;
      float4* op = (float4*)(p.out + (size_t)m * 1024 + n);
      op[0] = a; op[1] = b;
      float sq = a.x * a.x + a.y * a.y + a.z * a.z + a.w * a.w + b.x * b.x + b.y * b.y + b.z * b.z + b.w * b.w;
      sq += __shfl_xor(sq, 1); sq += __shfl_xor(sq, 2); sq += __shfl_xor(sq, 4); sq += __shfl_xor(sq, 8);
      if ((ltid() & 15) == 0) PSUM[(size_t)nt * NX + m] = sq;
    });
  }
}

__device__ __forceinline__ void phase7(const Params& p) {
  const float* PSUM = (const float*)(p.ws + OFF_PSUM);
  const int tid__ = ltid(); const int lane = tid__ & 63, wave = tid__ >> 6;
  for (int it = blockIdx.x; it < NX / 4; it += gridDim.x) {
    int row = it * 4 + wave;
    float tot = 0.f;
#pragma unroll
    for (int j = 0; j < 8; ++j) tot += PSUM[(size_t)j * NX + row];
    float rs = rsqrtf(tot * (1.f / 1024.f) + 1e-6f);
    float4* o = (float4*)(p.out + (size_t)row * 1024);
#pragma unroll
    for (int i = 0; i < 4; ++i) {
      float4 v = o[lane + 64 * i]; float4 w = ((const float4*)p.final_w)[lane + 64 * i];
      v.x *= rs * w.x; v.y *= rs * w.y; v.z *= rs * w.z; v.w *= rs * w.w;
      o[lane + 64 * i] = v;
    }
  }
}

__global__ void __launch_bounds__(256, 2) mega(Params p) {
  extern __shared__ __attribute__((aligned(16))) unsigned char smem[];
  cg::grid_group grid = cg::this_grid();
  unsigned* bar = (unsigned*)(p.ws + OFF_BAR);
  phase0(p, smem); grid.sync();
  unsigned bk = 0;
  phase1(p, smem); grid_barrier(bar, ++bk);
  if (P2_SPLIT > 0) { phase2<false>(p, smem, 0, P2_SPLIT * 16, blockIdx.x, gridDim.x); grid_barrier(bar, ++bk); }
  phase3(p, smem, bar); grid_barrier(bar, ++bk);
  phase4(p, smem); grid_barrier(bar, ++bk);
  phase5(p, smem); grid_barrier(bar, ++bk);
  phase6(p, smem); grid_barrier(bar, ++bk);
  phase7(p);
}

extern "C" void kernel_launch(void* const* d_in, const int* in_sizes, int n_in, void* d_out, int out_size, void* d_ws, size_t ws_size, hipStream_t stream) {
  static int grid_blocks = 0;
  if (!grid_blocks) {
    int dev = 0, cus = 0, per_cu = 0;
    hipGetDevice(&dev);
    hipDeviceGetAttribute(&cus, hipDeviceAttributeMultiprocessorCount, dev);
    hipFuncSetAttribute((const void*)mega, hipFuncAttributeMaxDynamicSharedMemorySize, SMEM_BYTES);
    hipOccupancyMaxActiveBlocksPerMultiprocessor(&per_cu, (const void*)mega, 256, SMEM_BYTES);
    if (per_cu < 1) per_cu = 1;
    if (per_cu > 2) per_cu = 2;
    grid_blocks = cus * per_cu;
    if (ws_size < WS_END) fprintf(stderr, "workspace too small: %zu < %zu\n", ws_size, (size_t)WS_END);
  }
  Params p{};
  p.x = (const float*)d_in[0]; p.meta = (const float*)d_in[1]; p.norm_w = (const float*)d_in[2]; p.w_in = (const float*)d_in[3];
  p.lq1 = (const float*)d_in[4]; p.lk1 = (const float*)d_in[5]; p.lq2 = (const float*)d_in[6]; p.lk2 = (const float*)d_in[7];
  p.attn_norm_w = (const float*)d_in[8]; p.conv_w = (const float*)d_in[9]; p.a_log = (const float*)d_in[10]; p.dt_bias = (const float*)d_in[11];
  p.dn_norm_w = (const float*)d_in[12]; p.w_a = (const float*)d_in[13]; p.w_d = (const float*)d_in[14]; p.w_o = (const float*)d_in[15]; p.final_w = (const float*)d_in[16];
  p.out = (float*)d_out; p.ws = (unsigned char*)d_ws;
  hipMemsetAsync((unsigned char*)d_ws + OFF_BAR, 0, 2048, stream);
  void* args[] = {&p};
  hipError_t e = hipLaunchCooperativeKernel((const void*)mega, dim3(grid_blocks), dim3(256), args, SMEM_BYTES, stream);
  if (e != hipSuccess) fprintf(stderr, "cooperative launch failed: %s (grid %d)\n", hipGetErrorString(e), grid_blocks);
}
```
